# Optimizing an MI355X kernel written in HIP

```python
import jax, jax.numpy as jnp
from jax import lax
import numpy as np

D_MODEL = 1024
BATCH = 8
SEQ = 4096
DEPTH = 4

GRID_W = 64
CTX_LEN = 256
N_MIXERS = 2
EXPAND = 2
D_INNER = EXPAND * D_MODEL
HG_HEAD_DIM = 128
HG_HEADS = D_INNER // HG_HEAD_DIM
HG_CHUNK = 32
N_HG_LAYERS = (DEPTH + 1) // 2
MLA_NOPE_DIM = 128
MLA_ROPE_DIM = 64
MLA_V_DIM = 128
MLA_HEADS = D_INNER // MLA_V_DIM
MLA_Q_RANK = D_MODEL // 4
MLA_KV_RANK = D_MODEL // 8
MLA_SCALE = (MLA_NOPE_DIM + MLA_ROPE_DIM) ** -0.5
N_MLA_LAYERS = DEPTH // 2
ROPE_THETA = 10000.0
ROPE_AXIS_DIM = MLA_ROPE_DIM // 2
Q_BLOCK = 128
NORM_EPS = 1e-6

kernel_name = "hybrid_hgrn2_mla_dit_trunk"


def _rmsnorm(x, g):
    xf = x.astype(jnp.float32)
    y = xf * lax.rsqrt(jnp.mean(xf * xf, axis=-1, keepdims=True) + NORM_EPS)
    return (y * g.astype(jnp.float32)).astype(x.dtype)


def _axial_rope(n_tokens):
    rows = n_tokens // GRID_W
    row = jnp.repeat(jnp.arange(rows, dtype=jnp.float32), GRID_W)
    col = jnp.tile(jnp.arange(GRID_W, dtype=jnp.float32), rows)
    inv = ROPE_THETA ** (-jnp.arange(0, ROPE_AXIS_DIM, 2, dtype=jnp.float32) / ROPE_AXIS_DIM)
    ang = jnp.concatenate([row[:, None] * inv, col[:, None] * inv], axis=-1)
    return jnp.cos(ang), jnp.sin(ang)


def _apply_rope(x, cos, sin):
    half = x.shape[-1] // 2
    x1 = x[..., :half].astype(jnp.float32)
    x2 = x[..., half:].astype(jnp.float32)
    return jnp.concatenate([x1 * cos - x2 * sin, x1 * sin + x2 * cos], axis=-1).astype(x.dtype)


def _hgrn2_scan(q, k, v, log_f, s0):
    B, L, H, _ = q.shape
    DV = v.shape[-1]
    n = L // HG_CHUNK

    def chunks(t):
        return jnp.moveaxis(t.astype(jnp.float32).reshape(B, n, HG_CHUNK, H, t.shape[-1]), 1, 0)

    tri = jnp.tril(jnp.ones((HG_CHUNK, HG_CHUNK), dtype=bool))[None, :, :, None, None]

    def step(S, xs):
        qc, kc, vc, lfc = xs
        b = jnp.cumsum(lfc, axis=1)
        b_last = b[:, -1]
        o_inter = jnp.einsum('bthk,bhkv->bthv', qc * jnp.exp(b), S)
        decay = jnp.exp(jnp.where(tri, b[:, :, None] - b[:, None, :], -jnp.inf))
        scores = jnp.einsum('bthk,btshk,bshk->bhts', qc, decay, kc)
        o_intra = jnp.einsum('bhts,bshv->bthv', scores, vc)
        S_new = jnp.exp(b_last)[..., None] * S + jnp.einsum(
            'bshk,bshv->bhkv', kc * jnp.exp(b_last[:, None] - b), vc)
        return S_new, o_inter + o_intra

    S, o = lax.scan(step, s0, (chunks(q), chunks(k), chunks(v), chunks(log_f)))
    return jnp.moveaxis(o, 0, 1).reshape(B, L, H, DV), S


def _hgrn2_bidir(q, v, gates, init_states):
    (k_f, lf_f), (k_b, lf_b) = gates
    rev = lambda t: jnp.flip(t, axis=1)
    o_f, s_f = _hgrn2_scan(q, k_f, v, lf_f, init_states[0])
    o_b, s_b = _hgrn2_scan(rev(q), rev(k_b), rev(v), rev(lf_b), init_states[1])
    return o_f + rev(o_b), (s_f, s_b)


def _hgrn2_mixer(h_lat, h_ctx, w_in, lb, o_gain, w_out):
    def project(h):
        B, L, _ = h.shape
        heads = lambda t: t.reshape(B, L, HG_HEADS, HG_HEAD_DIM)
        q, i_in, f_fw, f_bw, z = jnp.split(h @ w_in, 5, axis=-1)
        gates = []
        for d, g in enumerate((f_fw, f_bw)):
            lbd = lb[d]
            gf = g.astype(jnp.float32)
            log_f = jnp.logaddexp(jnp.log(lbd), jnp.log1p(-lbd) + jax.nn.log_sigmoid(gf))
            k = (1.0 - lbd) * jax.nn.sigmoid(-gf)
            gates.append((heads(k), heads(log_f)))
        return heads(jax.nn.silu(q)), heads(i_in), gates, z

    def readout(o, z):
        B, L = o.shape[:2]
        o = _rmsnorm(o, o_gain).reshape(B, L, D_INNER).astype(z.dtype)
        return (o * jax.nn.silu(z)) @ w_out

    Bsz = h_lat.shape[0]
    s0 = jnp.zeros((Bsz, HG_HEADS, HG_HEAD_DIM, HG_HEAD_DIM), jnp.float32)
    q_c, v_c, gates_c, z_c = project(h_ctx)
    o_c, ctx_states = _hgrn2_bidir(q_c, v_c, gates_c, (s0, s0))
    q_l, v_l, gates_l, z_l = project(h_lat)
    o_l, _ = _hgrn2_bidir(q_l, v_l, gates_l, ctx_states)
    return readout(o_l, z_l), readout(o_c, z_c)


def _attend(q_nope, q_pe, k_nope, k_pe, v):
    s = (jnp.einsum('bqhd,bkhd->bhqk', q_nope, k_nope, preferred_element_type=jnp.float32)
         + jnp.einsum('bqhr,bkr->bhqk', q_pe, k_pe, preferred_element_type=jnp.float32))
    p = jax.nn.softmax(s * MLA_SCALE, axis=-1)
    return jnp.einsum('bhqk,bkhd->bqhd', p.astype(v.dtype), v)


def _blocked_attend(q_nope, q_pe, k_nope, k_pe, v):
    B, L, H, _ = q_nope.shape
    n = L // Q_BLOCK
    blk = lambda t: jnp.moveaxis(t.reshape(B, n, Q_BLOCK, H, t.shape[-1]), 1, 0)
    o = lax.map(lambda qs: _attend(qs[0], qs[1], k_nope, k_pe, v), (blk(q_nope), blk(q_pe)))
    return jnp.moveaxis(o, 0, 1).reshape(B, L, H, v.shape[-1])


def _mla_mixer(h_lat, h_ctx, w_in, qa_norm, w_qb, kva_norm, w_kvb, w_out, cos, sin, need_ctx):
    splits = [MLA_Q_RANK, MLA_Q_RANK + MLA_KV_RANK, MLA_Q_RANK + MLA_KV_RANK + MLA_ROPE_DIM]

    def queries(q_a):
        B, L, _ = q_a.shape
        q = (_rmsnorm(q_a, qa_norm) @ w_qb).reshape(B, L, MLA_HEADS, MLA_NOPE_DIM + MLA_ROPE_DIM)
        return q[..., :MLA_NOPE_DIM], q[..., MLA_NOPE_DIM:]

    def keys_values(kv_a):
        B, L, _ = kv_a.shape
        kv = (_rmsnorm(kv_a, kva_norm) @ w_kvb).reshape(B, L, MLA_HEADS, MLA_NOPE_DIM + MLA_V_DIM)
        return kv[..., :MLA_NOPE_DIM], kv[..., MLA_NOPE_DIM:]

    def readout(o, z):
        B, L = o.shape[:2]
        return (o.reshape(B, L, D_INNER) * jax.nn.silu(z)) @ w_out

    q_a, kv_a, k_pe, z = jnp.split(h_lat @ w_in, splits, axis=-1)
    q_nope, q_pe = queries(q_a)
    q_pe = _apply_rope(q_pe, cos[None, :, None, :], sin[None, :, None, :])
    k_pe = _apply_rope(k_pe, cos[None], sin[None])
    k_nope, v = keys_values(kv_a)

    if need_ctx:
        qc_a, kvc_a, kc_pe, z_c = jnp.split(h_ctx @ w_in, splits, axis=-1)
    else:
        kvc_a, kc_pe = jnp.split(h_ctx @ w_in[:, splits[0]:splits[2]], [MLA_KV_RANK], axis=-1)
    kc_nope, v_c = keys_values(kvc_a)

    o_lat = _blocked_attend(q_nope, q_pe,
                            jnp.concatenate([kc_nope, k_nope], axis=1),
                            jnp.concatenate([kc_pe, k_pe], axis=1),
                            jnp.concatenate([v_c, v], axis=1))
    y_lat = readout(o_lat, z)
    y_ctx = None
    if need_ctx:
        qc_nope, qc_pe = queries(qc_a)
        y_ctx = readout(_attend(qc_nope, qc_pe, kc_nope, kc_pe, v_c), z_c)
    return y_lat, y_ctx


def setup_inputs(seed: int = 0) -> dict:
    key = jax.random.key(seed)
    ks = jax.random.split(key, 20)
    f32 = jnp.float32

    def w(k, shape, fan_in):
        return jax.random.normal(k, shape, f32) * fan_in ** -0.5

    def gain(k, shape):
        return 1.0 + 0.1 * jax.random.normal(k, shape, f32)

    mla_in = MLA_Q_RANK + MLA_KV_RANK + MLA_ROPE_DIM + D_INNER
    return {
        "x": jax.random.normal(ks[0], (BATCH, SEQ, D_MODEL), f32),
        "c": jax.random.normal(ks[1], (BATCH, D_MODEL), f32),
        "ctx": jax.random.normal(ks[2], (BATCH, CTX_LEN, D_MODEL), f32),
        "c_ctx": jax.random.normal(ks[3], (D_MODEL,), f32),
        "ada_w": w(ks[4], (DEPTH, D_MODEL, 3 * D_MODEL), D_MODEL),
        "ada_b": 0.02 * jax.random.normal(ks[5], (DEPTH, 3 * D_MODEL), f32),
        "norm_pre": gain(ks[6], (DEPTH, D_MODEL)),
        "norm_post": gain(ks[7], (DEPTH, D_MODEL)),
        "hg_w_in": w(ks[8], (N_HG_LAYERS, D_MODEL, 5 * D_INNER), D_MODEL),
        "hg_lb_logits": jax.random.normal(ks[9], (N_HG_LAYERS, 2, D_INNER), f32),
        "hg_o_norm": gain(ks[10], (N_HG_LAYERS, HG_HEAD_DIM)),
        "hg_w_out": w(ks[11], (N_HG_LAYERS, D_INNER, D_MODEL), D_INNER),
        "mla_w_in": w(ks[12], (N_MLA_LAYERS, D_MODEL, mla_in), D_MODEL),
        "mla_qa_norm": gain(ks[13], (N_MLA_LAYERS, MLA_Q_RANK)),
        "mla_w_qb": w(ks[14], (N_MLA_LAYERS, MLA_Q_RANK, MLA_HEADS * (MLA_NOPE_DIM + MLA_ROPE_DIM)), MLA_Q_RANK),
        "mla_kva_norm": gain(ks[15], (N_MLA_LAYERS, MLA_KV_RANK)),
        "mla_w_kvb": w(ks[16], (N_MLA_LAYERS, MLA_KV_RANK, MLA_HEADS * (MLA_NOPE_DIM + MLA_V_DIM)), MLA_KV_RANK),
        "mla_w_out": w(ks[17], (N_MLA_LAYERS, D_INNER, D_MODEL), D_INNER),
    }


def reference(x, c, ctx, c_ctx, ada_w, ada_b, norm_pre, norm_post,
              hg_w_in, hg_lb_logits, hg_o_norm, hg_w_out,
              mla_w_in, mla_qa_norm, mla_w_qb, mla_kva_norm, mla_w_kvb, mla_w_out):
    cos, sin = _axial_rope(x.shape[1])
    p = jax.nn.softmax(hg_lb_logits.astype(jnp.float32), axis=0)
    lower_bounds = jnp.cumsum(p, axis=0) - p[0:1]
    silu_c = jax.nn.silu(c)
    silu_cc = jax.nn.silu(c_ctx)
    x_lat, x_ctx = x, ctx
    for i in range(DEPTH):
        need_ctx = i < DEPTH - 1
        j = i // N_MIXERS
        mod_lat = (silu_c @ ada_w[i] + ada_b[i])[:, None, :]
        mod_ctx = silu_cc @ ada_w[i] + ada_b[i]
        sh_l, sc_l, gt_l = jnp.split(mod_lat, 3, axis=-1)
        sh_c, sc_c, gt_c = jnp.split(mod_ctx, 3, axis=-1)
        h_lat = _rmsnorm(x_lat, norm_pre[i]) * (1.0 + sc_l) + sh_l
        h_ctx = _rmsnorm(x_ctx, norm_pre[i]) * (1.0 + sc_c) + sh_c
        if i % N_MIXERS == 0:
            y_lat, y_ctx = _hgrn2_mixer(h_lat, h_ctx, hg_w_in[j], lower_bounds[j],
                                        hg_o_norm[j], hg_w_out[j])
        else:
            y_lat, y_ctx = _mla_mixer(h_lat, h_ctx, mla_w_in[j], mla_qa_norm[j], mla_w_qb[j],
                                      mla_kva_norm[j], mla_w_kvb[j], mla_w_out[j],
                                      cos, sin, need_ctx)
        x_lat = x_lat + gt_l * _rmsnorm(y_lat, norm_post[i])
        if need_ctx:
            x_ctx = x_ctx + gt_c * _rmsnorm(y_ctx, norm_post[i])
    return x_lat
```

```cpp
#include <hip/hip_runtime.h>
#include <hip/hip_cooperative_groups.h>
#include <cstdio>
#include <cstdint>
namespace cg = cooperative_groups;

#define LAS __attribute__((address_space(3)))
typedef unsigned short bf16_t;
typedef short bf16x8 __attribute__((ext_vector_type(8)));
typedef short s16x4 __attribute__((ext_vector_type(4)));
typedef float f32x4 __attribute__((ext_vector_type(4)));
typedef float f32x2 __attribute__((ext_vector_type(2)));
typedef float f32x16 __attribute__((ext_vector_type(16)));
typedef unsigned u32x4 __attribute__((ext_vector_type(4)));
typedef unsigned u32x2 __attribute__((ext_vector_type(2)));
typedef _Float16 h16x2 __attribute__((ext_vector_type(2)));

constexpr int NB = 8, LAT = 4096, CTXL = 256, TPB = LAT + CTXL  , T = NB * TPB  , TH = T / 2  ;
constexpr int DM = 1024, DI = 2048;
constexpr float EPS = 1e-6f;
constexpr float CQ = 0.07216878364870322f * 1.4426950408889634f;

constexpr size_t MiB = 1u << 20;
constexpr size_t WS_MODS = 64 * 1024;
constexpr size_t WS_TAB = 640 * 1024;
constexpr size_t WS_XCTX = 1 * MiB;
constexpr size_t WS_W = 9 * MiB;
constexpr size_t WS_HG_WIN = WS_W, WS_HG_WOUT = WS_W + 20 * MiB;
constexpr size_t WS_ML_WIN = WS_W, WS_ML_WQ = WS_W + 5 * MiB, WS_ML_WVB = WS_W + 7 * MiB, WS_ML_WOUT = WS_W + 8 * MiB;
constexpr size_t WS_ACT = 35 * MiB;
constexpr size_t HG_ARR = (size_t)TH * DI * 2;
constexpr size_t WS_HG_P = WS_ACT;
constexpr size_t WS_HG_OF = WS_ACT + 5 * HG_ARR, WS_HG_OB = WS_HG_OF + HG_ARR;
constexpr size_t WS_HG_H = WS_HG_OF;
constexpr size_t WS_HG_GATED = WS_HG_P;
constexpr size_t WS_HG_Y = WS_HG_P + HG_ARR;
constexpr size_t WS_ML_H = WS_ACT;
constexpr size_t WS_ML_QR = WS_ACT + 68 * MiB;
constexpr size_t WS_ML_Y = WS_ACT;
constexpr size_t WS_ML_SMALL = WS_ACT + 136 * MiB;
constexpr size_t WS_ML_QN = WS_ACT + 170 * MiB;
constexpr size_t WS_ML_KC = WS_ACT + 187 * MiB;
constexpr size_t WS_ML_Z = WS_ACT + 200 * MiB;
constexpr size_t WS_ML_QO = WS_ACT + 336 * MiB;
static_assert(WS_HG_OB + HG_ARR <= 512 * MiB && WS_ML_QO + 136 * MiB <= 512 * MiB, "ws map");

constexpr int LDS_BYTES = 147456;

typedef __bf16 bf16x2_t __attribute__((ext_vector_type(2)));
__device__ __forceinline__ unsigned cvt_pk_bf16(float lo, float hi) { f32x2 v = {lo, hi}; bf16x2_t b = __builtin_convertvector(v, bf16x2_t); return __builtin_bit_cast(unsigned, b); }
__device__ __forceinline__ unsigned f2bf(float f) { unsigned u = __builtin_bit_cast(unsigned, f); return (u + 0x7fffu + ((u >> 16) & 1u)) >> 16; }
__device__ __forceinline__ float bf2f(unsigned short b) { return __builtin_bit_cast(float, (unsigned)b << 16); }
__device__ __forceinline__ float bflo(unsigned w) { return __builtin_bit_cast(float, w << 16); }
__device__ __forceinline__ float bfhi(unsigned w) { return __builtin_bit_cast(float, w & 0xffff0000u); }
__device__ __forceinline__ unsigned pk_h2(float a, float b) { h16x2 v = {(_Float16)a, (_Float16)b}; return __builtin_bit_cast(unsigned, v); }
__device__ __forceinline__ float silu_f(float x) { return x * __builtin_amdgcn_rcpf(1.f + __expf(-x)); }
__device__ __forceinline__ int opaque_bid() { int b = blockIdx.x; asm volatile("" : "+s"(b)); return b; }
__device__ __forceinline__ int launder_s(int v) { asm volatile("" : "+s"(v)); return v; }
__device__ __forceinline__ int opaque_tid(int& tidv) { asm volatile("" : "+v"(tidv)); return tidv; }
__device__ __forceinline__ float shx(float v, int o, int lane) { return __builtin_bit_cast(float, __builtin_amdgcn_ds_bpermute((lane ^ o) << 2, __builtin_bit_cast(int, v))); }
__device__ __forceinline__ float wave_sum(float v, int lane) {
#pragma unroll
    for (int o = 1; o < 64; o <<= 1) v += shx(v, o, lane);
    return v;
}

namespace pg8 {
constexpr int BM = 256, BK = 64, HALF = 128, HTB = HALF * BK * 2, STAGE_BYTES = 8 * HTB, NXCD = 8, WGM = 8;
__host__ __device__ __forceinline__ int lds_byte(int r, int c) { const int st = (r >> 4) * 2 + (c >> 5), rr = r & 15, cc = c & 31, ob = rr * 64 + cc * 2; return st * 1024 + (ob ^ (((ob >> 9) & 1) << 5)); }
__host__ __device__ __forceinline__ void stage_rc(int b, int& R, int& C) { const int st = b / 1024, sb = b % 1024, swz = sb ^ (((sb >> 9) & 1) << 5); R = (st >> 1) * 16 + swz / 64; C = (st & 1) * 32 + (swz % 64) / 2; }
__host__ __device__ __forceinline__ int perm32(int rho) { const int n = rho >> 4, i = rho & 15; return 8 * (i >> 2) + 4 * n + (i & 3); }
struct Unit { int pm, pn; };
struct Gemm { const bf16_t* A; const bf16_t* Bt; int M, N, K, lda, ldb, acol_pn; };
struct StaticOrder {
    int nM, nN, nwg, G, c;
    __device__ void init(int M, int N, int G_, int c_) { nM = M / BM; nN = N / BM; nwg = nM * nN; G = G_; c = c_; }
    __device__ bool next(int i, Unit& u) const {
        const long L = (long)i * G + c; if (L >= nwg) return false;
        int wgid = (int)L; { const int q = nwg / NXCD, r = nwg % NXCD, xcd = wgid % NXCD, off = wgid / NXCD; wgid = (xcd < r ? xcd * (q + 1) : r * (q + 1) + (xcd - r) * q) + off; }
        const int nig = WGM * nN, gid = wgid / nig, fm = gid * WGM, gsz = (nM - fm) < WGM ? (nM - fm) : WGM;
        u.pm = fm + ((wgid % nig) % gsz); u.pn = (wgid % nig) / gsz; return true;
    }
};
template <class Epi>
__device__ __forceinline__ void gemm_phase(LAS unsigned char* lds, const Gemm g, const StaticOrder& S, const Epi& E, int& tidv) {
    const int tid = opaque_tid(tidv), wid = __builtin_amdgcn_readfirstlane(tid >> 6), lane = tid & 63, wr = wid >> 2, wc = wid & 3, fr = lane & 15, fq = lane >> 4;
    const int K = g.K, nt = K / BK;
    unsigned voffA[2], voffB[2];
#pragma unroll
    for (int i = 0; i < 2; ++i) { int R, C; stage_rc(tid * 16 + i * 8192, R, C); const int Rb = (R & ~31) + perm32(R & 31);
        voffA[i] = (unsigned)(R * g.lda + C) * 2u; voffB[i] = (unsigned)(Rb * g.ldb + C) * 2u; }
    const unsigned kstep = (unsigned)(BK * 2);
    const unsigned hA = (unsigned)HALF * (unsigned)g.lda * 2u, hB = (unsigned)HALF * (unsigned)g.ldb * 2u;
    const unsigned tA = 2u * hA, tB = 2u * hB;
    const unsigned ldsw = (unsigned)wid * 1024u;
    const int aoff = lds_byte(wr * 64 + fr, fq * 8), boff = lds_byte(wc * 32 + fr, fq * 8);
#define PG8_SA(b, h) (((b) * 2 + (h)) * HTB)
#define PG8_SB(b, h) ((4 + (b) * 2 + (h)) * HTB)
#define PG8_STAGE(bufoff, gbase, voff) do { _Pragma("unroll") for (int _i = 0; _i < 2; ++_i) \
        __builtin_amdgcn_global_load_lds((const unsigned*)((const char*)(gbase) + (voff)[_i]), (LAS unsigned*)(lds + (bufoff) + ldsw + _i * 8192), 16, 0, 0); } while (0)
#define PG8_LDA(dst, b, h) do { _Pragma("unroll") for (int m = 0; m < 4; ++m) _Pragma("unroll") for (int k = 0; k < 2; ++k) dst[m][k] = *(const LAS bf16x8*)(lds + PG8_SA(b, h) + aoff + m * 2048 + k * 1024); } while (0)
#define PG8_LDB(dst, b, h) do { _Pragma("unroll") for (int n = 0; n < 2; ++n) _Pragma("unroll") for (int k = 0; k < 2; ++k) dst[n][k] = *(const LAS bf16x8*)(lds + PG8_SB(b, h) + boff + n * 2048 + k * 1024); } while (0)
#define PG8_MMA(ai, bj, At, Bt) do { __builtin_amdgcn_s_setprio(1); _Pragma("unroll") for (int m = 0; m < 4; ++m) _Pragma("unroll") for (int n = 0; n < 2; ++n) _Pragma("unroll") for (int k = 0; k < 2; ++k) \
        acc[ai][bj][m][n] = __builtin_amdgcn_mfma_f32_16x16x32_bf16(Bt[n][k], At[m][k], acc[ai][bj][m][n], 0, 0, 0); __builtin_amdgcn_s_setprio(0); } while (0)
#define PG8_WAIT_V(n) asm volatile("s_waitcnt vmcnt(" #n ")" ::: "memory")
#define PG8_WAIT_L(n) asm volatile("s_waitcnt lgkmcnt(" #n ")" ::: "memory")
#define PG8_BAR __builtin_amdgcn_s_barrier()
#define PG8_SCHED __builtin_amdgcn_sched_barrier(0)
    Unit cur, nxt; int ui = 0;
    if (!S.next(0, cur)) return;
    f32x4 acc[2][2][4][2];
#pragma unroll
    for (int a = 0; a < 2; ++a)
#pragma unroll
        for (int b = 0; b < 2; ++b)
#pragma unroll
            for (int m = 0; m < 4; ++m)
#pragma unroll
                for (int n = 0; n < 2; ++n) acc[a][b][m][n] = (f32x4){0.f, 0.f, 0.f, 0.f};
    bf16x8 At[4][2], B0[2][2], B1[2][2];
    const char* cA = (const char*)g.A + (size_t)((unsigned)cur.pm * tA + (unsigned)(cur.pn * g.acol_pn * 2)); const char* cB = (const char*)g.Bt + (size_t)((unsigned)cur.pn * tB);
    PG8_STAGE(PG8_SB(0, 0), cB, voffB); PG8_STAGE(PG8_SB(0, 1), cB + hB, voffB); PG8_STAGE(PG8_SA(0, 0), cA, voffA); PG8_STAGE(PG8_SA(0, 1), cA + hA, voffA);
    if (wr == 1) PG8_BAR;
    PG8_WAIT_V(2); PG8_BAR;
    PG8_STAGE(PG8_SB(1, 0), cB + kstep, voffB); PG8_STAGE(PG8_SA(1, 0), cA + kstep, voffA); PG8_STAGE(PG8_SB(1, 1), cB + hB + kstep, voffB);
    PG8_WAIT_V(6); PG8_BAR;
    for (;;) {
        const bool has_next = S.next(ui + 1, nxt);
        const char* nA = has_next ? (const char*)g.A + (size_t)((unsigned)nxt.pm * tA + (unsigned)(nxt.pn * g.acol_pn * 2)) : cA; const char* nB = has_next ? (const char*)g.Bt + (size_t)((unsigned)nxt.pn * tB) : cB;
        for (int t = 0; t < nt; t += 2) {
            const bool last = (t == nt - 2);
            const char* a1 = cA + (unsigned)(t + 1) * kstep;
            const char* a2 = last ? nA : cA + (unsigned)(t + 2) * kstep; const char* b2 = last ? nB : cB + (unsigned)(t + 2) * kstep;
            const char* a3 = a2 + kstep; const char* b3 = b2 + kstep;
            PG8_LDB(B0, 0, 0); PG8_LDB(B1, 0, 1); PG8_SCHED; PG8_LDA(At, 0, 0); PG8_STAGE(PG8_SA(1, 1), a1 + hA, voffA);
            PG8_WAIT_V(8); PG8_WAIT_L(0); PG8_BAR; PG8_MMA(0, 0, At, B0); PG8_MMA(0, 1, At, B1); PG8_BAR; PG8_SCHED;
            PG8_LDA(At, 0, 1); PG8_STAGE(PG8_SB(0, 0), b2, voffB); PG8_STAGE(PG8_SB(0, 1), b2 + hB, voffB); PG8_STAGE(PG8_SA(0, 0), a2, voffA);
            PG8_WAIT_V(8); PG8_WAIT_L(0); PG8_BAR; PG8_MMA(1, 0, At, B0); PG8_MMA(1, 1, At, B1); PG8_BAR; PG8_SCHED;
            PG8_LDB(B0, 1, 0); PG8_LDB(B1, 1, 1); PG8_SCHED; PG8_LDA(At, 1, 0); PG8_STAGE(PG8_SA(0, 1), a2 + hA, voffA);
            PG8_WAIT_V(8); PG8_WAIT_L(0); PG8_BAR; PG8_MMA(0, 0, At, B0); PG8_MMA(0, 1, At, B1); PG8_BAR; PG8_SCHED;
            PG8_LDA(At, 1, 1); PG8_STAGE(PG8_SB(1, 0), b3, voffB); PG8_STAGE(PG8_SB(1, 1), b3 + hB, voffB); PG8_STAGE(PG8_SA(1, 0), a3, voffA);
            PG8_WAIT_V(8); PG8_WAIT_L(0); PG8_BAR; PG8_MMA(1, 0, At, B0); PG8_MMA(1, 1, At, B1); PG8_BAR; PG8_SCHED;
        }
        if (wr == 0) PG8_BAR;
        E(acc, cur, wr, wc, fr, fq);
        if (!has_next) break;
#pragma unroll
        for (int a = 0; a < 2; ++a)
#pragma unroll
            for (int b = 0; b < 2; ++b)
#pragma unroll
                for (int m = 0; m < 4; ++m)
#pragma unroll
                    for (int n = 0; n < 2; ++n) acc[a][b][m][n] = (f32x4){0.f, 0.f, 0.f, 0.f};
        cur = nxt; cA = nA; cB = nB; ++ui;
        if (wr == 1) PG8_BAR;
    }
    PG8_WAIT_V(0);
    PG8_BAR;
#undef PG8_SA
#undef PG8_SB
#undef PG8_STAGE
#undef PG8_LDA
#undef PG8_LDB
#undef PG8_MMA
#undef PG8_WAIT_V
#undef PG8_WAIT_L
#undef PG8_BAR
#undef PG8_SCHED
}

typedef f32x4 Acc[2][2][4][2];
struct EpiHgIn {
    bf16_t* base;
    __device__ __forceinline__ void operator()(const Acc& acc, const Unit& u, int wr, int wc, int fr, int fq) const {
        const int which = u.pn >> 3, colt = (u.pn & 7) * 256;
        bf16_t* ob = base + (size_t)which * ((size_t)TH * DI);
        const int row0 = u.pm * 256 + wr * 64 + fr, col0 = colt + wc * 32 + 8 * fq;
#pragma unroll
        for (int ai = 0; ai < 2; ++ai)
#pragma unroll
            for (int m = 0; m < 4; ++m) { bf16_t* rowp = ob + (size_t)(row0 + ai * 128 + m * 16) * DI + col0;
#pragma unroll
                for (int bj = 0; bj < 2; ++bj) { f32x4 v0 = acc[ai][bj][m][0], v1 = acc[ai][bj][m][1]; u32x4 w;
                    if (which == 0) {
#pragma unroll
                        for (int e = 0; e < 4; ++e) { v0[e] = silu_f(v0[e]); v1[e] = silu_f(v1[e]); } }
                    if (which == 2 || which == 3) { w.x = pk_h2(v0[0], v0[1]); w.y = pk_h2(v0[2], v0[3]); w.z = pk_h2(v1[0], v1[1]); w.w = pk_h2(v1[2], v1[3]); }
                    else { w.x = cvt_pk_bf16(v0[0], v0[1]); w.y = cvt_pk_bf16(v0[2], v0[3]); w.z = cvt_pk_bf16(v1[0], v1[1]); w.w = cvt_pk_bf16(v1[2], v1[3]); }
                    *(u32x4*)(rowp + bj * 128) = w; } }
    }
};
struct EpiF32 {
    float* out;
    __device__ __forceinline__ void operator()(const Acc& acc, const Unit& u, int wr, int wc, int fr, int fq) const {
        const int row0 = u.pm * 256 + wr * 64 + fr, col0 = u.pn * 256 + wc * 32 + 8 * fq;
#pragma unroll
        for (int ai = 0; ai < 2; ++ai)
#pragma unroll
            for (int m = 0; m < 4; ++m) { float* rowp = out + (size_t)(row0 + ai * 128 + m * 16) * DM + col0;
#pragma unroll
                for (int bj = 0; bj < 2; ++bj) { *(f32x4*)(rowp + bj * 128) = acc[ai][bj][m][0]; *(f32x4*)(rowp + bj * 128 + 4) = acc[ai][bj][m][1]; } }
    }
};
struct EpiMlaIn {
    bf16_t* small; bf16_t* z;
    __device__ __forceinline__ void operator()(const Acc& acc, const Unit& u, int wr, int wc, int fr, int fq) const {
        const bool sm = u.pn < 2; bf16_t* ob = sm ? small : z; const int ld = sm ? 512 : DI;
        const int row0 = u.pm * 256 + wr * 64 + fr, col0 = (sm ? u.pn : u.pn - 2) * 256 + wc * 32 + 8 * fq;
#pragma unroll
        for (int ai = 0; ai < 2; ++ai)
#pragma unroll
            for (int m = 0; m < 4; ++m) { bf16_t* rowp = ob + (size_t)(row0 + ai * 128 + m * 16) * ld + col0;
#pragma unroll
                for (int bj = 0; bj < 2; ++bj) { const f32x4 v0 = acc[ai][bj][m][0], v1 = acc[ai][bj][m][1]; u32x4 w;
                    w.x = cvt_pk_bf16(v0[0], v0[1]); w.y = cvt_pk_bf16(v0[2], v0[3]); w.z = cvt_pk_bf16(v1[0], v1[1]); w.w = cvt_pk_bf16(v1[2], v1[3]);
                    *(u32x4*)(rowp + bj * 128) = w; } }
    }
};
struct EpiQ {
    bf16_t* qn; bf16_t* qr;
    __device__ __forceinline__ void operator()(const Acc& acc, const Unit& u, int wr, int wc, int fr, int fq) const {
        const bool nope = u.pn < 8; bf16_t* ob = nope ? qn : qr; const int ld = nope ? DI : 1024;
        const int row0 = u.pm * 256 + wr * 64 + fr, col0 = (nope ? u.pn : u.pn - 8) * 256 + wc * 32 + 8 * fq;
#pragma unroll
        for (int ai = 0; ai < 2; ++ai)
#pragma unroll
            for (int m = 0; m < 4; ++m) { bf16_t* rowp = ob + (size_t)(row0 + ai * 128 + m * 16) * ld + col0;
#pragma unroll
                for (int bj = 0; bj < 2; ++bj) { const f32x4 v0 = acc[ai][bj][m][0] * CQ, v1 = acc[ai][bj][m][1] * CQ; u32x4 w;
                    w.x = cvt_pk_bf16(v0[0], v0[1]); w.y = cvt_pk_bf16(v0[2], v0[3]); w.z = cvt_pk_bf16(v1[0], v1[1]); w.w = cvt_pk_bf16(v1[2], v1[3]);
                    *(u32x4*)(rowp + bj * 128) = w; } }
    }
};
struct EpiVb {
    bf16_t* out; const bf16_t* z;
    __device__ __forceinline__ void operator()(const Acc& acc, const Unit& u, int wr, int wc, int fr, int fq) const {
        const int row0 = u.pm * 256 + wr * 64 + fr, col0 = u.pn * 256 + wc * 32 + 8 * fq;
#pragma unroll
        for (int ai = 0; ai < 2; ++ai)
#pragma unroll
            for (int m = 0; m < 4; ++m) { const size_t off = (size_t)(row0 + ai * 128 + m * 16) * DI + col0;
#pragma unroll
                for (int bj = 0; bj < 2; ++bj) { const f32x4 v0 = acc[ai][bj][m][0], v1 = acc[ai][bj][m][1]; const u32x4 zz = *(const u32x4*)(z + off + bj * 128); u32x4 w;
                    w.x = cvt_pk_bf16(v0[0] * silu_f(bflo(zz.x)), v0[1] * silu_f(bfhi(zz.x))); w.y = cvt_pk_bf16(v0[2] * silu_f(bflo(zz.y)), v0[3] * silu_f(bfhi(zz.y)));
                    w.z = cvt_pk_bf16(v1[0] * silu_f(bflo(zz.z)), v1[1] * silu_f(bfhi(zz.z))); w.w = cvt_pk_bf16(v1[2] * silu_f(bflo(zz.w)), v1[3] * silu_f(bfhi(zz.w)));
                    *(u32x4*)(out + off + bj * 128) = w; } }
    }
};
}

namespace att {
constexpr int NW = 8, QBLK = 32, KVBLK = 64;
constexpr int SHM_V = 16384, SHM_KN = 16384, SHM_KR = 8192;
constexpr int OFF_V = 0, OFF_KN = 2 * SHM_V, OFF_KR = OFF_KN + 2 * SHM_KN, OFF_WS = OFF_KR + 2 * SHM_KR, SHM_ATTN = OFF_WS + NW * 64 * 4;
constexpr float THR2 = 11.0f;
#define KSWZ(row, colB) ((row) * 256 + ((colB) ^ (((row) & 7) << 4)))
#define KRSWZ(row, colB) ((row) * 128 + ((colB) ^ (((row) & 7) << 4)))
#define SBAR() __builtin_amdgcn_sched_barrier(0)
__device__ __forceinline__ int crow(int r, int hi) { return (r & 3) + 8 * (r >> 2) + 4 * hi; }
__device__ __forceinline__ void partialSM(f32x16& p0, f32x16& p1, float& m_reg, float& mn, float& alpha) {
    float pmax = p0[0];
#pragma unroll
    for (int r = 1; r < 16; ++r) pmax = fmaxf(pmax, p0[r]);
#pragma unroll
    for (int r = 0; r < 16; ++r) pmax = fmaxf(pmax, p1[r]);
    { auto rr = __builtin_amdgcn_permlane32_swap(__float_as_uint(pmax), __float_as_uint(pmax), false, false);
      pmax = fmaxf(__uint_as_float(rr[0]), __uint_as_float(rr[1])); }
    if (__builtin_expect(__all(pmax - m_reg <= THR2), 1)) { mn = m_reg; alpha = 1.f; }
    else { mn = fmaxf(m_reg, pmax); alpha = __builtin_amdgcn_exp2f(m_reg - mn); m_reg = mn; }
#pragma unroll
    for (int r = 0; r < 16; ++r) p0[r] = p0[r] - mn;
#pragma unroll
    for (int r = 0; r < 16; ++r) p1[r] = p1[r] - mn;
#pragma unroll
    for (int r = 0; r < 16; ++r) p0[r] = __builtin_amdgcn_exp2f(p0[r]);
}
__device__ __forceinline__ void finishSM(f32x16& p0, f32x16& p1, float alpha, float& l_reg, bf16x8& pa0, bf16x8& pa1, bf16x8& pa2, bf16x8& pa3) {
#pragma unroll
    for (int r = 0; r < 16; ++r) p1[r] = __builtin_amdgcn_exp2f(p1[r]);
    float ps = 0;
#pragma unroll
    for (int r = 0; r < 16; ++r) ps += p0[r];
#pragma unroll
    for (int r = 0; r < 16; ++r) ps += p1[r];
    { auto rr = __builtin_amdgcn_permlane32_swap(__float_as_uint(ps), __float_as_uint(ps), false, false);
      ps = __uint_as_float(rr[0]) + __uint_as_float(rr[1]); }
    l_reg = l_reg * alpha + ps;
#define PK4(P, BASE, OUT) do { unsigned a0 = cvt_pk_bf16(P[BASE + 0], P[BASE + 1]), a1 = cvt_pk_bf16(P[BASE + 2], P[BASE + 3]);   \
    unsigned b0 = cvt_pk_bf16(P[BASE + 4], P[BASE + 5]), b1 = cvt_pk_bf16(P[BASE + 6], P[BASE + 7]);                              \
    auto r0 = __builtin_amdgcn_permlane32_swap(a0, b0, false, false); auto r1 = __builtin_amdgcn_permlane32_swap(a1, b1, false, false); \
    u32x4 w = {r0[0], r1[0], r0[1], r1[1]}; OUT = *reinterpret_cast<bf16x8*>(&w); } while (0)
    PK4(p0, 0, pa0); PK4(p0, 8, pa1); PK4(p1, 0, pa2); PK4(p1, 8, pa3);
#undef PK4
}
__device__ __forceinline__ void qkt(f32x16& p0, f32x16& p1, const char* Kn, const char* Kr, const bf16x8* qr, int r32, int hi) {
    p0 = f32x16{}; p1 = f32x16{};
#pragma unroll
    for (int d0 = 0; d0 < 8; ++d0) { const int cb = (d0 * 16 + hi * 8) * 2;
        const bf16x8 b0 = *reinterpret_cast<const bf16x8*>(Kn + KSWZ(r32, cb));
        const bf16x8 b1 = *reinterpret_cast<const bf16x8*>(Kn + KSWZ(32 + r32, cb));
        p0 = __builtin_amdgcn_mfma_f32_32x32x16_bf16(b0, qr[d0], p0, 0, 0, 0);
        p1 = __builtin_amdgcn_mfma_f32_32x32x16_bf16(b1, qr[d0], p1, 0, 0, 0); }
#pragma unroll
    for (int d0 = 0; d0 < 4; ++d0) { const int cb = (d0 * 16 + hi * 8) * 2;
        const bf16x8 b0 = *reinterpret_cast<const bf16x8*>(Kr + KRSWZ(r32, cb));
        const bf16x8 b1 = *reinterpret_cast<const bf16x8*>(Kr + KRSWZ(32 + r32, cb));
        p0 = __builtin_amdgcn_mfma_f32_32x32x16_bf16(b0, qr[8 + d0], p0, 0, 0, 0);
        p1 = __builtin_amdgcn_mfma_f32_32x32x16_bf16(b1, qr[8 + d0], p1, 0, 0, 0); }
}
__device__ __forceinline__ int v_st(int k, int c) { const int kk = (k & ~0xC) | ((k & 4) << 1) | ((k & 8) >> 1); return ((kk >> 3) * 4 + (c >> 5)) * 512 + ((kk & 7) * 32 + (c & 31)) * 2; }
__device__ __forceinline__ int v_rd_base(int lane) { return ((lane & 3) << 3) | (((lane >> 2) & 3) << 6) | (((lane >> 4) & 1) << 5) | (((lane >> 5) & 1) << 8); }
constexpr int v_rd_off(int d0, int ks, int half) { return d0 * 512 + ks * 4096 + half * 2048; }
template <int OFF> __device__ __forceinline__ s16x4 tr_read(int vb) {
    s16x4 r; asm volatile("ds_read_b64_tr_b16 %0, %1 offset:%2" : "=&v"(r) : "v"(vb), "i"(OFF) : "memory"); return r;
}
template <int D0> __device__ __forceinline__ void pv_one(f32x16& od, int vb, bf16x8 pa0, bf16x8 pa1, bf16x8 pa2, bf16x8 pa3) {
    const s16x4 l0 = tr_read<v_rd_off(D0, 0, 0)>(vb), h0 = tr_read<v_rd_off(D0, 0, 1)>(vb), l1 = tr_read<v_rd_off(D0, 1, 0)>(vb), h1 = tr_read<v_rd_off(D0, 1, 1)>(vb);
    const s16x4 l2 = tr_read<v_rd_off(D0, 2, 0)>(vb), h2 = tr_read<v_rd_off(D0, 2, 1)>(vb), l3 = tr_read<v_rd_off(D0, 3, 0)>(vb), h3 = tr_read<v_rd_off(D0, 3, 1)>(vb);
    asm volatile("s_waitcnt lgkmcnt(0)" ::: "memory"); SBAR();
#define PK(L, H) (bf16x8){L[0], L[1], L[2], L[3], H[0], H[1], H[2], H[3]}
    od = __builtin_amdgcn_mfma_f32_32x32x16_bf16(pa0, PK(l0, h0), od, 0, 0, 0);
    od = __builtin_amdgcn_mfma_f32_32x32x16_bf16(pa1, PK(l1, h1), od, 0, 0, 0);
    od = __builtin_amdgcn_mfma_f32_32x32x16_bf16(pa2, PK(l2, h2), od, 0, 0, 0);
    od = __builtin_amdgcn_mfma_f32_32x32x16_bf16(pa3, PK(l3, h3), od, 0, 0, 0);
#undef PK
}
__device__ __forceinline__ void pv_d0(f32x16* o, int vb, bf16x8 pa0, bf16x8 pa1, bf16x8 pa2, bf16x8 pa3) {
    pv_one<0>(o[0], vb, pa0, pa1, pa2, pa3); pv_one<1>(o[1], vb, pa0, pa1, pa2, pa3); pv_one<2>(o[2], vb, pa0, pa1, pa2, pa3); pv_one<3>(o[3], vb, pa0, pa1, pa2, pa3);
}
__device__ __forceinline__ void attn_unit(const bf16_t* Qn, const bf16_t* Qr, const bf16_t* __restrict__ Kh, bf16_t* Ob, int seq, char* lds, int tq0  , const float* tab, int& tidv) {
    const int tid = opaque_tid(tidv), wid = tid >> 6, lane = tid & 63, r32 = lane & 31, hi = lane >> 5;
    char* V_lds = lds + OFF_V; char* KN_lds = lds + OFF_KN; char* KR_lds = lds + OFF_KR;
    float* ws = (float*)(lds + OFF_WS) + wid * 64; float* li_l = ws; float* al_l = ws + 32;
    float m_reg = -1e30f, l_reg = 0; f32x16 o[4] = {}; bf16x8 qr[12];
    { const bf16_t* Qw = Qn + (long)(wid * QBLK + r32) * DI + hi * 8;
#pragma unroll
      for (int d0 = 0; d0 < 8; ++d0) qr[d0] = *reinterpret_cast<const bf16x8*>(Qw + d0 * 16);
      const bf16_t* Qw2 = Qr + (long)(wid * QBLK + r32) * 1024 + hi * 8;
#pragma unroll
      for (int d0 = 0; d0 < 4; ++d0) qr[8 + d0] = *reinterpret_cast<const bf16x8*>(Qw2 + d0 * 16);
      if (tq0 >= 0) { const int t = tq0 + wid * QBLK + r32;
#pragma unroll
        for (int d0 = 0; d0 < 4; ++d0) { const int pos = d0 < 2 ? (t >> 6) : (t & 63); const float* tp = tab + (pos * 16 + (d0 & 1) * 8 + hi * 4) * 2;
            const f32x4 c0 = *(const f32x4*)tp, c1 = *(const f32x4*)(tp + 4); const u32x4 q = __builtin_bit_cast(u32x4, qr[8 + d0]); u32x4 w;
            { const float a = bflo(q.x), b = bfhi(q.x); w.x = cvt_pk_bf16(a * c0[0] - b * c0[1], a * c0[1] + b * c0[0]); }
            { const float a = bflo(q.y), b = bfhi(q.y); w.y = cvt_pk_bf16(a * c0[2] - b * c0[3], a * c0[3] + b * c0[2]); }
            { const float a = bflo(q.z), b = bfhi(q.z); w.z = cvt_pk_bf16(a * c1[0] - b * c1[1], a * c1[1] + b * c1[0]); }
            { const float a = bflo(q.w), b = bfhi(q.w); w.w = cvt_pk_bf16(a * c1[2] - b * c1[3], a * c1[3] + b * c1[2]); }
            qr[8 + d0] = __builtin_bit_cast(bf16x8, w); } } }
    const int sr = tid >> 4, sc = (tid & 15) * 8, vst0 = v_st(sr, sc), vst1 = v_st(32 + sr, sc);
    const int rr_ = tid >> 3, rc = (tid & 7) * 8;
    const int vb0 = (int)(uintptr_t)V_lds + v_rd_base(lane);
    struct { bf16x8 ks0, ks1, kr; } sr_[1];
#define SLOAD(i, k0) do { sr_[i].ks0 = *reinterpret_cast<const bf16x8*>(&Kh[(long)((k0) + sr) * 192 + sc]); sr_[i].ks1 = *reinterpret_cast<const bf16x8*>(&Kh[(long)((k0) + 32 + sr) * 192 + sc]); \
    sr_[i].kr = *reinterpret_cast<const bf16x8*>(&Kh[(long)((k0) + rr_) * 192 + 128 + rc]); } while (0)
#define SWRITE(b, i) do { *(bf16x8*)(V_lds + (b) * SHM_V + vst0) = sr_[i].ks0; *(bf16x8*)(V_lds + (b) * SHM_V + vst1) = sr_[i].ks1; const int kc = sc * 2; \
    *(bf16x8*)(KN_lds + (b) * SHM_KN + KSWZ(sr, kc)) = sr_[i].ks0; *(bf16x8*)(KN_lds + (b) * SHM_KN + KSWZ(32 + sr, kc)) = sr_[i].ks1; \
    *(bf16x8*)(KR_lds + (b) * SHM_KR + KRSWZ(rr_, rc * 2)) = sr_[i].kr; } while (0)
#define SWAIT() asm volatile("s_waitcnt vmcnt(0)" ::: "memory")
#define RESC(a) do { if (__any((a) < 1.f)) { if (hi == 0) al_l[r32] = (a); asm volatile("s_waitcnt lgkmcnt(0)" ::: "memory"); \
    _Pragma("unroll") for (int d = 0; d < 4; ++d) _Pragma("unroll") for (int r = 0; r < 16; ++r) o[d][r] *= al_l[crow(r, hi)]; } } while (0)
    f32x16 pA0, pA1, pB0, pB1; float mnA, mnB, alA, alB; bf16x8 pa0, pa1, pa2, pa3; const int NT = seq / KVBLK;
    constexpr int SE = 0, SO = 0;
    SLOAD(SE, 0); asm volatile("s_waitcnt vmcnt(0)" ::: "memory"); SWRITE(0, SE); __syncthreads();
    qkt(pA0, pA1, KN_lds, KR_lds, qr, r32, hi); partialSM(pA0, pA1, m_reg, mnA, alA);
    SLOAD(SO, KVBLK);
    SWAIT(); SWRITE(1, SO); __syncthreads();
    for (int j = 1; j + 1 < NT; j += 2) {
        SBAR(); qkt(pB0, pB1, KN_lds + SHM_KN, KR_lds + SHM_KR, qr, r32, hi);
        finishSM(pA0, pA1, alA, l_reg, pa0, pa1, pa2, pa3); SBAR();
        SLOAD(SO, (j + 1) * KVBLK); SBAR();
        pv_d0(o, vb0, pa0, pa1, pa2, pa3); partialSM(pB0, pB1, m_reg, mnB, alB);
        __syncthreads(); SWAIT(); SWRITE(0, SE);
        RESC(alB); __syncthreads();
        SBAR(); qkt(pA0, pA1, KN_lds, KR_lds, qr, r32, hi);
        finishSM(pB0, pB1, alB, l_reg, pa0, pa1, pa2, pa3); SBAR();
        SLOAD(SE, (j + 2) * KVBLK); SBAR();
        pv_d0(o, vb0 + SHM_V, pa0, pa1, pa2, pa3); partialSM(pA0, pA1, m_reg, mnA, alA);
        __syncthreads(); SWAIT(); SWRITE(1, SO);
        RESC(alA); __syncthreads();
    }
    SBAR(); qkt(pB0, pB1, KN_lds + SHM_KN, KR_lds + SHM_KR, qr, r32, hi);
    finishSM(pA0, pA1, alA, l_reg, pa0, pa1, pa2, pa3); SBAR();
    pv_d0(o, vb0, pa0, pa1, pa2, pa3); partialSM(pB0, pB1, m_reg, mnB, alB);
    __syncthreads(); RESC(alB);
    finishSM(pB0, pB1, alB, l_reg, pa0, pa1, pa2, pa3); SBAR();
    pv_d0(o, vb0 + SHM_V, pa0, pa1, pa2, pa3);
    if (hi == 0) li_l[r32] = l_reg; asm volatile("s_waitcnt lgkmcnt(0)" ::: "memory");
    float rli[16];
#pragma unroll
    for (int r = 0; r < 16; ++r) rli[r] = __builtin_amdgcn_rcpf(li_l[crow(r, hi)]);
    bf16_t* Ow = Ob + (long)(wid * QBLK) * DI;
#pragma unroll
    for (int r = 0; r < 16; ++r) { const int orow = crow(r, hi);
#pragma unroll
        for (int d0 = 0; d0 < 4; ++d0) Ow[(long)orow * DI + d0 * 32 + r32] = (bf16_t)f2bf(o[d0][r] * rli[r]); }
    __syncthreads();
#undef SLOAD
#undef SWRITE
#undef SWAIT
#undef RESC
}
}

struct Params {
    const float *x, *c, *ctx, *c_ctx, *ada_w, *ada_b, *norm_pre, *norm_post, *hg_w_in, *hg_lb, *hg_o_norm, *hg_w_out,
                *mla_w_in, *mla_qa_norm, *mla_w_qb, *mla_kva_norm, *mla_w_kvb, *mla_w_out;
    float* out; unsigned char* ws;
};

__device__ __forceinline__ void transpose_item(const float* W, int ldw, int src_n0, int k0, bf16_t* WT, int ldt, int dst_row0, LAS float* scr, int lane) {
#pragma unroll 8
    for (int i = 0; i < 32; ++i) { const int kk = 2 * i + (lane >> 5); scr[kk * 33 + (lane & 31)] = src_n0 >= 0 ? W[(size_t)(k0 + kk) * ldw + src_n0 + (lane & 31)] : 0.f; }
    asm volatile("s_waitcnt lgkmcnt(0)" ::: "memory");
    const int c = lane & 7;
#pragma unroll
    for (int j = 0; j < 4; ++j) { const int n = (lane >> 3) + 8 * j; const LAS float* s = scr + (8 * c) * 33 + n;
        u32x4 o; o.x = cvt_pk_bf16(s[0 * 33], s[1 * 33]); o.y = cvt_pk_bf16(s[2 * 33], s[3 * 33]); o.z = cvt_pk_bf16(s[4 * 33], s[5 * 33]); o.w = cvt_pk_bf16(s[6 * 33], s[7 * 33]);
        *(u32x4*)(WT + (size_t)(dst_row0 + n) * ldt + k0 + 8 * c) = o; }
    asm volatile("s_waitcnt lgkmcnt(0)" ::: "memory");
}
__device__ __forceinline__ void conv_hgrn_weights(const float* hg_w_in, const float* hg_w_out, unsigned char* ws, int j, LAS unsigned char* lds, int gw, int NGW, int wave, int lane) {
    LAS float* scr = (LAS float*)(lds + wave * 16384);
    const float* win = hg_w_in + (size_t)j * DM * 10240; const float* wout = hg_w_out + (size_t)j * DI * DM;
    bf16_t* win_t = (bf16_t*)(ws + WS_HG_WIN); bf16_t* wout_t = (bf16_t*)(ws + WS_HG_WOUT);
    constexpr int I_IN = 16 * 320, I_OUT = 32 * 32;
    for (int it = gw; it < I_IN + I_OUT; it += NGW) {
        if (it < I_IN) { const int kb = it / 320, nb = it % 320; transpose_item(win, 10240, nb * 32, kb * 64, win_t, DM, nb * 32, scr, lane); }
        else { const int r = it - I_IN, kb = r / 32, nb = r % 32; transpose_item(wout, DM, nb * 32, kb * 64, wout_t, DI, nb * 32, scr, lane); }
    }
}
__device__ __forceinline__ void conv_mla_weights(const float* mla_w_in, const float* mla_w_out, const float* mla_w_qb, const float* mla_w_kvb, unsigned char* ws, int j, LAS unsigned char* lds, int gw, int NGW, int wave, int lane) {
    LAS float* scr = (LAS float*)(lds + wave * 16384);
    const float* win = mla_w_in + (size_t)j * DM * 2496; const float* wout = mla_w_out + (size_t)j * DI * DM;
    const float* wqb = mla_w_qb + (size_t)j * 256 * 3072; const float* wkvb = mla_w_kvb + (size_t)j * 128 * 4096;
    bf16_t* win_t = (bf16_t*)(ws + WS_ML_WIN); bf16_t* wout_t = (bf16_t*)(ws + WS_ML_WOUT);
    bf16_t* wq_t = (bf16_t*)(ws + WS_ML_WQ); bf16_t* wvb_t = (bf16_t*)(ws + WS_ML_WVB);
    constexpr int I_IN = 16 * 80, I_OUT = 32 * 32;
    for (int it = gw; it < I_IN + I_OUT; it += NGW) {
        if (it < I_IN) { const int kb = it / 80, nb = it % 80; const int src = nb < 14 ? nb * 32 : (nb < 16 ? -1 : nb * 32 - 64);
            transpose_item(win, 2496, src, kb * 64, win_t, DM, nb * 32, scr, lane); }
        else { const int r = it - I_IN, kb = r / 32, nb = r % 32; transpose_item(wout, DM, nb * 32, kb * 64, wout_t, DI, nb * 32, scr, lane); }
    }
    const int gt = gw * 64 + lane, NGT = NGW * 64;
    for (int idx = gt; idx < 2048 * 64; idx += NGT) { const int r0 = (idx & 63) * 4, n = idx >> 6, h = n >> 7, c = n & 127;
        const f32x4* kv = (const f32x4*)(wkvb + (size_t)c * 4096 + h * 256); float a[4] = {0.f, 0.f, 0.f, 0.f};
        for (int d4 = 0; d4 < 32; ++d4) { const f32x4 kk = kv[d4];
#pragma unroll
            for (int e = 0; e < 4; ++e) { const f32x4 q = *(const f32x4*)(wqb + (size_t)(r0 + e) * 3072 + h * 192 + d4 * 4); a[e] += q[0] * kk[0] + q[1] * kk[1] + q[2] * kk[2] + q[3] * kk[3]; } }
        u32x2 w; w.x = cvt_pk_bf16(a[0], a[1]); w.y = cvt_pk_bf16(a[2], a[3]); *(u32x2*)(wq_t + (size_t)n * 256 + r0) = w; }
    for (int idx = gt; idx < 1024 * 64; idx += NGT) { const int r0 = (idx & 63) * 4, nn = idx >> 6, h = nn >> 6, jj = (nn & 63) >> 1, e = nn & 1; const int col = h * 192 + 128 + jj + 32 * e;
        u32x2 w; w.x = cvt_pk_bf16(wqb[(size_t)r0 * 3072 + col], wqb[(size_t)(r0 + 1) * 3072 + col]); w.y = cvt_pk_bf16(wqb[(size_t)(r0 + 2) * 3072 + col], wqb[(size_t)(r0 + 3) * 3072 + col]);
        *(u32x2*)(wq_t + (size_t)(2048 + nn) * 256 + r0) = w; }
    for (int idx = gt; idx < 2048 * 64; idx += NGT) { const int k0 = (idx & 63) * 4, n = idx >> 6, pp = n >> 8, jj = n & 255; u32x2 w = {0u, 0u};
        if ((k0 >> 7) == (jj >> 7)) { const int col = (2 * pp + (jj >> 7)) * 256 + 128 + (jj & 127); const int kr = k0 & 127;
            w.x = cvt_pk_bf16(wkvb[(size_t)kr * 4096 + col], wkvb[(size_t)(kr + 1) * 4096 + col]); w.y = cvt_pk_bf16(wkvb[(size_t)(kr + 2) * 4096 + col], wkvb[(size_t)(kr + 3) * 4096 + col]); }
        *(u32x2*)(wvb_t + (size_t)n * 256 + k0) = w; }
}
__device__ __forceinline__ void mods_phase(const float* pc, const float* pcc, const float* ada_w, const float* ada_b, unsigned char* ws, LAS unsigned char* lds, int tid) {
    LAS float* sc = (LAS float*)lds;
    LAS float* red = (LAS float*)(lds + 36864);
    for (int i = tid; i < 9 * 1024; i += 512) { const float v = i < 8192 ? pc[i] : pcc[i - 8192]; sc[i] = silu_f(v); }
    __syncthreads();
    float* mods = (float*)(ws + WS_MODS);
    const int col = tid & 31, kg = tid >> 5;
    for (int item = blockIdx.x; item < 4 * 96; item += gridDim.x) {
        const int layer = item / 96, n0 = (item % 96) * 32;
        const float* w = ada_w + (size_t)layer * DM * 3072 + n0 + col;
        float a[9];
#pragma unroll
        for (int q = 0; q < 9; ++q) a[q] = 0.f;
#pragma unroll 4
        for (int k = kg; k < DM; k += 16) { const float wv = w[(size_t)k * 3072];
#pragma unroll
            for (int q = 0; q < 9; ++q) a[q] += sc[q * 1024 + k] * wv; }
#pragma unroll
        for (int q = 0; q < 9; ++q) red[(kg * 9 + q) * 32 + col] = a[q];
        __syncthreads();
        if (tid < 288) { const int q = tid >> 5, cc = tid & 31; float s = 0.f;
#pragma unroll
            for (int g = 0; g < 16; ++g) s += red[(g * 9 + q) * 32 + cc];
            mods[((size_t)layer * 9 + q) * 3072 + n0 + cc] = s + ada_b[layer * 3072 + n0 + cc]; }
        __syncthreads();
    }
    if (blockIdx.x == gridDim.x - 1) { float* tab = (float*)(ws + WS_TAB);
        for (int i = tid; i < 1024; i += 512) { const int pos = i >> 4, m = i & 15; const float inv = __builtin_amdgcn_exp2f(-(float)m * (13.287712379549449f / 16.f)); const float ang = (float)pos * inv;
            tab[2 * i] = __cosf(ang); tab[2 * i + 1] = __sinf(ang); } }
}
__device__ __forceinline__ void row_info(int r, int& b, int& i) { b = r / TPB; i = r - b * TPB; }
__device__ __forceinline__ void pre_rows(const float* lat, const float* ctx, const float* mods_l, const float* npre, bf16_t* H, int r0, int r1, int gw, int NGW, int lane) {
    for (int r = r0 + gw; r < r1; r += NGW) { int b, i; row_info(r, b, i);
        const float* xr = i < CTXL ? ctx + (size_t)(b * CTXL + i) * DM : lat + (size_t)(b * LAT + i - CTXL) * DM;
        const float* mod = mods_l + (size_t)(i < CTXL ? 8 : b) * 3072;
        f32x4 v[4]; float ss = 0.f;
#pragma unroll
        for (int q = 0; q < 4; ++q) { v[q] = *(const f32x4*)(xr + 4 * lane + 256 * q); ss += (v[q].x * v[q].x + v[q].y * v[q].y) + (v[q].z * v[q].z + v[q].w * v[q].w); }
        const float rstd = __builtin_amdgcn_rsqf(wave_sum(ss, lane) * (1.f / DM) + EPS);
        bf16_t* hr = H + (size_t)(r - r0) * DM;
#pragma unroll
        for (int q = 0; q < 4; ++q) { const int cc = 4 * lane + 256 * q; const f32x4 g = *(const f32x4*)(npre + cc), sh = *(const f32x4*)(mod + cc), sc = *(const f32x4*)(mod + 1024 + cc);
            const f32x4 h = v[q] * rstd * g * (sc + 1.f) + sh; u32x2 w; w.x = cvt_pk_bf16(h.x, h.y); w.y = cvt_pk_bf16(h.z, h.w); *(u32x2*)(hr + cc) = w; } }
}
__device__ __forceinline__ void post_rows(const float* slat, const float* sctx, float* dlat, float* dctx, const float* Y, const float* mods_l, const float* npost, int r0, int r1, bool write_ctx, int gw, int NGW, int lane) {
    for (int r = r0 + gw; r < r1; r += NGW) { int b, i; row_info(r, b, i);
        if (i < CTXL && !write_ctx) continue;
        const size_t off = i < CTXL ? (size_t)(b * CTXL + i) * DM : (size_t)(b * LAT + i - CTXL) * DM;
        const float* xr = (i < CTXL ? sctx : slat) + off; float* dr = (i < CTXL ? dctx : dlat) + off;
        const float* mod = mods_l + (size_t)(i < CTXL ? 8 : b) * 3072 + 2048;
        const float* yr = Y + (size_t)(r - r0) * DM;
        f32x4 v[4]; float ss = 0.f;
#pragma unroll
        for (int q = 0; q < 4; ++q) { v[q] = *(const f32x4*)(yr + 4 * lane + 256 * q); ss += (v[q].x * v[q].x + v[q].y * v[q].y) + (v[q].z * v[q].z + v[q].w * v[q].w); }
        const float rstd = __builtin_amdgcn_rsqf(wave_sum(ss, lane) * (1.f / DM) + EPS);
#pragma unroll
        for (int q = 0; q < 4; ++q) { const int cc = 4 * lane + 256 * q; const f32x4 g = *(const f32x4*)(npost + cc), gt = *(const f32x4*)(mod + cc), xv = *(const f32x4*)(xr + cc);
            *(f32x4*)(dr + cc) = xv + gt * (v[q] * rstd * g); } }
}
__device__ __forceinline__ void hg_gate_rows(const bf16_t* OF, const bf16_t* OB, const bf16_t* Z, const float* ogain, bf16_t* G, int gw, int NGW, int lane) {
    for (int r = gw; r < TH; r += NGW) {
#pragma unroll
        for (int it = 0; it < 4; ++it) { const size_t off = (size_t)r * DI + (it * 64 + lane) * 8; const int gc = (lane & 15) * 8;
            const u32x4 a = *(const u32x4*)(OF + off), b = *(const u32x4*)(OB + off), z = *(const u32x4*)(Z + off);
            float o[8]; o[0] = bflo(a.x) + bflo(b.x); o[1] = bfhi(a.x) + bfhi(b.x); o[2] = bflo(a.y) + bflo(b.y); o[3] = bfhi(a.y) + bfhi(b.y);
            o[4] = bflo(a.z) + bflo(b.z); o[5] = bfhi(a.z) + bfhi(b.z); o[6] = bflo(a.w) + bflo(b.w); o[7] = bfhi(a.w) + bfhi(b.w);
            float ss = 0.f;
#pragma unroll
            for (int e = 0; e < 8; ++e) ss += o[e] * o[e];
            ss += shx(ss, 1, lane); ss += shx(ss, 2, lane); ss += shx(ss, 4, lane); ss += shx(ss, 8, lane);
            const float rstd = __builtin_amdgcn_rsqf(ss * (1.f / 128.f) + EPS);
            const f32x4 g0 = *(const f32x4*)(ogain + gc), g1 = *(const f32x4*)(ogain + gc + 4);
            float zz[8] = {bflo(z.x), bfhi(z.x), bflo(z.y), bfhi(z.y), bflo(z.z), bfhi(z.z), bflo(z.w), bfhi(z.w)};
            const float gg[8] = {g0.x, g0.y, g0.z, g0.w, g1.x, g1.y, g1.z, g1.w};
            float y[8];
#pragma unroll
            for (int e = 0; e < 8; ++e) y[e] = o[e] * rstd * gg[e] * silu_f(zz[e]);
            u32x4 w; w.x = cvt_pk_bf16(y[0], y[1]); w.y = cvt_pk_bf16(y[2], y[3]); w.z = cvt_pk_bf16(y[4], y[5]); w.w = cvt_pk_bf16(y[6], y[7]);
            *(u32x4*)(G + off) = w; } }
}
__device__ __forceinline__ void mla_norm_rows(const bf16_t* SM, const float* qag, const float* kvg, const float* tab, bf16_t* QN, bf16_t* KC, int gw, int NGW, int lane) {
    for (int r = gw; r < T; r += NGW) { int b, i; row_info(r, b, i);
        const u32x4 a = *(const u32x4*)(SM + (size_t)r * 512 + lane * 8);
        float v[8] = {bflo(a.x), bfhi(a.x), bflo(a.y), bfhi(a.y), bflo(a.z), bfhi(a.z), bflo(a.w), bfhi(a.w)};
        float ss = 0.f;
#pragma unroll
        for (int e = 0; e < 8; ++e) ss += v[e] * v[e];
        const float sq = wave_sum(lane < 32 ? ss : 0.f, lane), skv = wave_sum((lane >= 32 && lane < 48) ? ss : 0.f, lane);
        float px[8];
#pragma unroll
        for (int e = 0; e < 8; ++e) px[e] = shx(v[e], 4, lane);
        if (lane < 32) { const float rstd = __builtin_amdgcn_rsqf(sq * (1.f / 256.f) + EPS); const f32x4 g0 = *(const f32x4*)(qag + lane * 8), g1 = *(const f32x4*)(qag + lane * 8 + 4);
            u32x4 w; w.x = cvt_pk_bf16(v[0] * rstd * g0.x, v[1] * rstd * g0.y); w.y = cvt_pk_bf16(v[2] * rstd * g0.z, v[3] * rstd * g0.w);
            w.z = cvt_pk_bf16(v[4] * rstd * g1.x, v[5] * rstd * g1.y); w.w = cvt_pk_bf16(v[6] * rstd * g1.z, v[7] * rstd * g1.w);
            *(u32x4*)(QN + (size_t)r * 256 + lane * 8) = w; }
        else if (lane < 48) { const int c0 = (lane - 32) * 8; const float rstd = __builtin_amdgcn_rsqf(skv * (1.f / 128.f) + EPS); const f32x4 g0 = *(const f32x4*)(kvg + c0), g1 = *(const f32x4*)(kvg + c0 + 4);
            u32x4 w; w.x = cvt_pk_bf16(v[0] * rstd * g0.x, v[1] * rstd * g0.y); w.y = cvt_pk_bf16(v[2] * rstd * g0.z, v[3] * rstd * g0.w);
            w.z = cvt_pk_bf16(v[4] * rstd * g1.x, v[5] * rstd * g1.y); w.w = cvt_pk_bf16(v[6] * rstd * g1.z, v[7] * rstd * g1.w);
            *(u32x4*)(KC + (size_t)r * 192 + c0) = w; }
        else if (lane < 52) { const int j0 = (lane - 48) * 8;
            float o[16];
#pragma unroll
            for (int e = 0; e < 8; ++e) { const int j = j0 + e; float cs = 1.f, sn = 0.f;
                if (i >= CTXL) { const int t = i - CTXL; const int pos = j < 16 ? (t >> 6) : (t & 63); const int m = j & 15; cs = tab[(pos * 16 + m) * 2]; sn = tab[(pos * 16 + m) * 2 + 1]; }
                o[2 * e] = v[e] * cs - px[e] * sn; o[2 * e + 1] = v[e] * sn + px[e] * cs; }
            u32x4 w0, w1; w0.x = cvt_pk_bf16(o[0], o[1]); w0.y = cvt_pk_bf16(o[2], o[3]); w0.z = cvt_pk_bf16(o[4], o[5]); w0.w = cvt_pk_bf16(o[6], o[7]);
            w1.x = cvt_pk_bf16(o[8], o[9]); w1.y = cvt_pk_bf16(o[10], o[11]); w1.z = cvt_pk_bf16(o[12], o[13]); w1.w = cvt_pk_bf16(o[14], o[15]);
            bf16_t* kp = KC + (size_t)r * 192 + 128 + 2 * j0; *(u32x4*)kp = w0; *(u32x4*)(kp + 8) = w1; }
    }
}

namespace scan {
constexpr int PQ = 136, PS = 40;
constexpr int O_QI = 0, O_QA = 8704, O_KA = 17408, O_KST = 26112, O_VT = 36352, O_P = 41472, O_ST0 = 44032, O_ST1 = 61440, O_BQ = 78848, O_DEC = 80896;
__device__ __forceinline__ int tok(int p, int j, int dir) { if (dir == 0) return 32 * p + j; const int cc = p < 8 ? 7 - p : 143 - p; return 32 * cc + 31 - j; }
__device__ __forceinline__ void scan_phase(LAS unsigned char* lds, const bf16_t* QH, const bf16_t* VH, const _Float16* GFB  , bf16_t* OFB  , const float* lbl  , int jl, int& tidv) {
    const int tid = opaque_tid(tidv), w = __builtin_amdgcn_readfirstlane(tid >> 6), lane = tid & 63, fr = lane & 15, fq = lane >> 4;
    const int k = tid & 127, qt = tid >> 7;
    const int vs = tid >> 4, vd = (tid & 15) * 4;
    LAS bf16_t* QI = (LAS bf16_t*)(lds + O_QI); LAS bf16_t* QA = (LAS bf16_t*)(lds + O_QA); LAS bf16_t* KA = (LAS bf16_t*)(lds + O_KA);
    LAS bf16_t* KST = (LAS bf16_t*)(lds + O_KST); LAS bf16_t* VT = (LAS bf16_t*)(lds + O_VT); LAS bf16_t* Pm = (LAS bf16_t*)(lds + O_P);
    LAS float* BQ = (LAS float*)(lds + O_BQ); LAS float* DEC = (LAS float*)(lds + O_DEC);
    for (int item = opaque_bid(); item < 256; item += gridDim.x) {
        const int dvh = item & 1, dir = (item >> 1) & 1, h = (item >> 2) & 15, bl = item >> 6;
        float lb = 0.f;
        if (jl == 1) { const float l0 = lbl[dir * DI + h * 128 + k], l1 = lbl[2 * DI + dir * DI + h * 128 + k]; lb = 1.f / (1.f + __expf(l0 - l1)); }
        const float oml = 1.f - lb;
        const size_t rowbase = (size_t)bl * TPB;
        const _Float16* Gp = GFB + (size_t)dir * ((size_t)TH * DI) + h * 128 + k;
        const bf16_t* Qp = QH + h * 128 + k;
        const bf16_t* Vp = VH + h * 128 + dvh * 64 + vd;
        bf16_t* Op = OFB + (size_t)dir * ((size_t)TH * DI) + h * 128 + dvh * 64;
        f32x4 S[4];
#pragma unroll
        for (int tv = 0; tv < 4; ++tv) S[tv] = (f32x4){0.f, 0.f, 0.f, 0.f};
        for (int i = tid; i < 17408 / 4; i += 512) ((LAS unsigned*)(lds + O_ST0))[i] = 0u;
        float gg[8], gq[8]; u32x2 vraw;
#define SC_LOAD(pp) do { _Pragma("unroll") for (int j = 0; j < 8; ++j) { const size_t ro = (rowbase + tok((pp), 8 * qt + j, dir)) * DI; gg[j] = (float)Gp[ro]; gq[j] = bf2f(Qp[ro]); } \
        vraw = *(const u32x2*)(Vp + (rowbase + tok((pp), vs, dir)) * DI); } while (0)
        SC_LOAD(0);
        __syncthreads();
        for (int p = 0; p < 136; ++p) {
            LAS bf16_t* STc = (LAS bf16_t*)(lds + ((p & 1) ? O_ST1 : O_ST0)); LAS bf16_t* STn = (LAS bf16_t*)(lds + ((p & 1) ? O_ST0 : O_ST1));
            float kk[8], cum[8]; float c = 0.f;
#pragma unroll
            for (int j = 0; j < 8; ++j) { const float g = fminf(fmaxf(gg[j], -30.f), 30.f); const float sig = __builtin_amdgcn_rcpf(1.f + __expf(-g));
                const float f = lb + oml * sig; c += __logf(f); cum[j] = c; kk[j] = oml * __builtin_amdgcn_rcpf(1.f + __expf(g)); }
            BQ[qt * 128 + k] = c;
            __syncthreads();
            { const float b0 = BQ[k], b1 = BQ[128 + k], b2 = BQ[256 + k], b3 = BQ[384 + k];
              const float pre = qt == 0 ? 0.f : (qt == 1 ? b0 : (qt == 2 ? b0 + b1 : b0 + b1 + b2));
              const float bmid = b0 + b1, blast = bmid + b2 + b3;
              u32x4 kst; unsigned kstw[4];
#pragma unroll
              for (int j = 0; j < 8; ++j) { const float b = pre + cum[j]; const int t = 8 * qt + j; const float q = gq[j];
                  QI[t * PQ + k] = (bf16_t)f2bf(q * __expf(b));
                  QA[t * PQ + k] = (bf16_t)f2bf(q * __expf(fminf(b - bmid, 80.f)));
                  KA[t * PQ + k] = (bf16_t)f2bf(kk[j] * __expf(fminf(bmid - b, 80.f)));
                  const float ks = kk[j] * __expf(blast - b);
                  if (j & 1) kstw[j >> 1] |= f2bf(ks) << 16; else kstw[j >> 1] = f2bf(ks); }
              kst.x = kstw[0]; kst.y = kstw[1]; kst.z = kstw[2]; kst.w = kstw[3];
              *(LAS u32x4*)(KST + k * PS + 8 * qt) = kst;
              if (qt == 0) DEC[k] = __expf(blast);
              VT[(vd + 0) * PS + vs] = (bf16_t)(vraw.x & 0xffffu); VT[(vd + 1) * PS + vs] = (bf16_t)(vraw.x >> 16);
              VT[(vd + 2) * PS + vs] = (bf16_t)(vraw.y & 0xffffu); VT[(vd + 3) * PS + vs] = (bf16_t)(vraw.y >> 16); }
            __syncthreads();
            if (p + 1 < 136) SC_LOAD(p + 1);
            if (w < 4) {
                const int tm = w >> 1, tn = w & 1; f32x4 sc = (f32x4){0.f, 0.f, 0.f, 0.f};
#pragma unroll
                for (int ks = 0; ks < 4; ++ks) { const bf16x8 X = *(const LAS bf16x8*)(QA + (16 * tm + fr) * PQ + 32 * ks + 8 * fq), Y = *(const LAS bf16x8*)(KA + (16 * tn + fr) * PQ + 32 * ks + 8 * fq);
                    sc = __builtin_amdgcn_mfma_f32_16x16x32_bf16(X, Y, sc, 0, 0, 0); }
                const int s = 16 * tn + fr;
#pragma unroll
                for (int e = 0; e < 4; ++e) { const int t = 16 * tm + 4 * fq + e; Pm[t * PS + s] = (bf16_t)((s <= t) ? f2bf(sc[e]) : 0u); }
            }
            const int tm = w >> 2, tn = w & 3; f32x4 oa = (f32x4){0.f, 0.f, 0.f, 0.f};
#pragma unroll
            for (int ks = 0; ks < 4; ++ks) { const bf16x8 X = *(const LAS bf16x8*)(QI + (16 * tm + fr) * PQ + 32 * ks + 8 * fq), Y = *(const LAS bf16x8*)(STc + (16 * tn + fr) * PQ + 32 * ks + 8 * fq);
                oa = __builtin_amdgcn_mfma_f32_16x16x32_bf16(X, Y, oa, 0, 0, 0); }
            { const bf16x8 X = *(const LAS bf16x8*)(KST + (16 * w + fr) * PS + 8 * fq); const f32x4 dec = *(const LAS f32x4*)(DEC + 16 * w + 4 * fq);
#pragma unroll
              for (int tv = 0; tv < 4; ++tv) { const bf16x8 Y = *(const LAS bf16x8*)(VT + (16 * tv + fr) * PS + 8 * fq);
                  S[tv] = __builtin_amdgcn_mfma_f32_16x16x32_bf16(X, Y, S[tv] * dec, 0, 0, 0);
                  u32x2 sw; sw.x = cvt_pk_bf16(S[tv][0], S[tv][1]); sw.y = cvt_pk_bf16(S[tv][2], S[tv][3]);
                  *(LAS u32x2*)(STn + (16 * tv + fr) * PQ + 16 * w + 4 * fq) = sw; } }
            __syncthreads();
            { const bf16x8 X = *(const LAS bf16x8*)(Pm + (16 * tm + fr) * PS + 8 * fq), Y = *(const LAS bf16x8*)(VT + (16 * tn + fr) * PS + 8 * fq);
              oa = __builtin_amdgcn_mfma_f32_16x16x32_bf16(X, Y, oa, 0, 0, 0); }
#pragma unroll
            for (int e = 0; e < 4; ++e) { const int t = 16 * tm + 4 * fq + e; Op[(rowbase + tok(p, t, dir)) * DI + 16 * tn + fr] = (bf16_t)f2bf(oa[e]); }
        }
        __syncthreads();
#undef SC_LOAD
    }
}
}

#ifndef GEMM_MASK
#define GEMM_MASK 63
#endif
#define GEMM_CALLN(n) do { if constexpr ((GEMM_MASK >> (n)) & 1) pg8::gemm_phase(lds, g, S, E, tidv); else { (void)g; (void)S; (void)E; } } while (0)
typedef const __attribute__((address_space(4))) Params* KParams;
__device__ __forceinline__ KParams kp_get() { KParams q = (KParams)__builtin_amdgcn_kernarg_segment_ptr(); asm volatile("" : "+s"(q)); return q; }
#define KP(field) (kp_get()->field)

#define IDS const int tid = opaque_tid(tidv), lane = tid & 63, wave = __builtin_amdgcn_readfirstlane(tid >> 6); (void)tid; (void)lane; (void)wave
#define LPV lp
#define GSYNC() do { asm volatile("s_waitcnt vmcnt(0) lgkmcnt(0)" ::: "memory"); grid.sync(); __builtin_amdgcn_fence(__ATOMIC_ACQUIRE, "agent"); asm volatile("s_waitcnt vmcnt(0)" ::: "memory"); } while (0)
#define GW (opaque_bid() * 8 + wave)
#define NGW_ ((int)gridDim.x * 8)
template <int lp, int hf>
__device__ __forceinline__ void hgrn_pass(LAS unsigned char* lds, unsigned char* lds_raw, cg::grid_group& grid, int& tidv) {

                const int r0 = hf * TH, r1 = r0 + TH;
                { IDS; KParams k = kp_get(); unsigned char* ws = k->ws;
                  pre_rows(LPV == 0 ? k->x : k->out, LPV == 0 ? k->ctx : (const float*)(ws + WS_XCTX), (const float*)(ws + WS_MODS) + (size_t)(2 * LPV) * 9 * 3072, k->norm_pre + (2 * LPV) * DM, (bf16_t*)(ws + WS_HG_H), r0, r1, GW, NGW_, lane); }
                GSYNC();
                { unsigned char* ws = KP(ws);
                  pg8::Gemm g{(const bf16_t*)(ws + WS_HG_H), (const bf16_t*)(ws + WS_HG_WIN), TH, 10240, DM, DM, DM, 0}; pg8::StaticOrder S; S.init(TH, 10240, (int)gridDim.x, opaque_bid());
                  pg8::EpiHgIn E{(bf16_t*)(ws + WS_HG_P)}; GEMM_CALLN(0); }
                GSYNC();
#ifndef NO_SCAN
                { KParams k = kp_get(); unsigned char* ws = k->ws; bf16_t* Pb = (bf16_t*)(ws + WS_HG_P);
                  scan::scan_phase(lds, Pb, Pb + (size_t)TH * DI, (const _Float16*)(Pb + 2 * (size_t)TH * DI), (bf16_t*)(ws + WS_HG_OF), k->hg_lb, LPV, tidv); }
#endif
                GSYNC();
                { IDS; KParams k = kp_get(); unsigned char* ws = k->ws; bf16_t* OFb = (bf16_t*)(ws + WS_HG_OF);
                  hg_gate_rows(OFb, OFb + (size_t)TH * DI, (const bf16_t*)(ws + WS_HG_P) + 4 * (size_t)TH * DI, k->hg_o_norm + LPV * 128, (bf16_t*)(ws + WS_HG_GATED), GW, NGW_, lane); }
                GSYNC();
                { unsigned char* ws = KP(ws);
                  pg8::Gemm g{(const bf16_t*)(ws + WS_HG_GATED), (const bf16_t*)(ws + WS_HG_WOUT), TH, DM, DI, DI, DI, 0}; pg8::StaticOrder S; S.init(TH, DM, (int)gridDim.x, opaque_bid());
                  pg8::EpiF32 E{(float*)(ws + WS_HG_Y)}; GEMM_CALLN(1); }
                GSYNC();
                { IDS; KParams k = kp_get(); unsigned char* ws = k->ws; float* xctx = (float*)(ws + WS_XCTX);
                  post_rows(LPV == 0 ? k->x : k->out, LPV == 0 ? k->ctx : (const float*)xctx, k->out, xctx, (const float*)(ws + WS_HG_Y), (const float*)(ws + WS_MODS) + (size_t)(2 * LPV) * 9 * 3072, k->norm_post + (2 * LPV) * DM, r0, r1, true, GW, NGW_, lane); }
                if (hf == 1) { IDS; KParams k = kp_get(); conv_mla_weights(k->mla_w_in, k->mla_w_out, k->mla_w_qb, k->mla_w_kvb, k->ws, LPV, lds, GW, NGW_, wave, lane); }
                GSYNC();
}
template <int lp>
__device__ __forceinline__ void mla_layer(LAS unsigned char* lds, unsigned char* lds_raw, cg::grid_group& grid, int& tidv) {
                        { IDS; KParams k = kp_get(); unsigned char* ws = k->ws;
              pre_rows(k->out, (const float*)(ws + WS_XCTX), (const float*)(ws + WS_MODS) + (size_t)(2 * LPV + 1) * 9 * 3072, k->norm_pre + (2 * LPV + 1) * DM, (bf16_t*)(ws + WS_ML_H), 0, T, GW, NGW_, lane); }
            GSYNC();
            { unsigned char* ws = KP(ws);
              pg8::Gemm g{(const bf16_t*)(ws + WS_ML_H), (const bf16_t*)(ws + WS_ML_WIN), T, 2560, DM, DM, DM, 0}; pg8::StaticOrder S; S.init(T, 2560, (int)gridDim.x, opaque_bid());
              pg8::EpiMlaIn E{(bf16_t*)(ws + WS_ML_SMALL), (bf16_t*)(ws + WS_ML_Z)}; GEMM_CALLN(2); }
            GSYNC();
            { IDS; KParams k = kp_get(); unsigned char* ws = k->ws;
              mla_norm_rows((const bf16_t*)(ws + WS_ML_SMALL), k->mla_qa_norm + LPV * 256, k->mla_kva_norm + LPV * 128, (const float*)(ws + WS_TAB), (bf16_t*)(ws + WS_ML_QN), (bf16_t*)(ws + WS_ML_KC), GW, NGW_, lane); }
            GSYNC();
            { unsigned char* ws = KP(ws);
              pg8::Gemm g{(const bf16_t*)(ws + WS_ML_QN), (const bf16_t*)(ws + WS_ML_WQ), T, 3072, 256, 256, 256, 0}; pg8::StaticOrder S; S.init(T, 3072, (int)gridDim.x, opaque_bid());
              pg8::EpiQ E{(bf16_t*)(ws + WS_ML_QO), (bf16_t*)(ws + WS_ML_QR)}; GEMM_CALLN(3); }
            GSYNC();
#ifndef NO_ATT
            { unsigned char* ws = KP(ws); bf16_t* QOb = (bf16_t*)(ws + WS_ML_QO); const bf16_t* QRb = (const bf16_t*)(ws + WS_ML_QR); const bf16_t* KCb = (const bf16_t*)(ws + WS_ML_KC);
              for (int u = opaque_bid(); u < 2048 + 128; u += gridDim.x) {
                int b, h, row0, seq, tq0;
                if (u < 2048) { b = u >> 8; h = (u >> 4) & 15; tq0 = (u & 15) * 256; row0 = b * TPB + CTXL + tq0; seq = TPB; }
                else { const int uc = u - 2048; b = uc >> 4; h = uc & 15; row0 = b * TPB; seq = CTXL; tq0 = -1; }
                att::attn_unit(QOb + (size_t)row0 * DI + h * 128, QRb + (size_t)row0 * 1024 + h * 64, KCb + (size_t)b * TPB * 192, QOb + (size_t)row0 * DI + h * 128, seq, (char*)lds_raw, tq0, (const float*)(ws + WS_TAB), tidv);
              } }
#endif
            GSYNC();
            { unsigned char* ws = KP(ws);
              pg8::Gemm g{(const bf16_t*)(ws + WS_ML_QO), (const bf16_t*)(ws + WS_ML_WVB), T, DI, 256, DI, 256, 256}; pg8::StaticOrder S; S.init(T, DI, (int)gridDim.x, opaque_bid());
              pg8::EpiVb E{(bf16_t*)(ws + WS_ML_QO), (const bf16_t*)(ws + WS_ML_Z)}; GEMM_CALLN(4); }
            GSYNC();
            { unsigned char* ws = KP(ws);
              pg8::Gemm g{(const bf16_t*)(ws + WS_ML_QO), (const bf16_t*)(ws + WS_ML_WOUT), T, DM, DI, DI, DI, 0}; pg8::StaticOrder S; S.init(T, DM, (int)gridDim.x, opaque_bid());
              pg8::EpiF32 E{(float*)(ws + WS_ML_Y)}; GEMM_CALLN(5); }
            GSYNC();
            { IDS; KParams k = kp_get(); unsigned char* ws = k->ws; float* xctx = (float*)(ws + WS_XCTX);
              post_rows(k->out, xctx, k->out, xctx, (const float*)(ws + WS_ML_Y), (const float*)(ws + WS_MODS) + (size_t)(2 * LPV + 1) * 9 * 3072, k->norm_post + (2 * LPV + 1) * DM, 0, T, LPV == 0, GW, NGW_, lane); }
            if (LPV == 0) { { IDS; KParams k = kp_get(); conv_hgrn_weights(k->hg_w_in, k->hg_w_out, k->ws, 1, lds, GW, NGW_, wave, lane); } GSYNC(); }
}
__global__ void __launch_bounds__(512, 2) mega_fwd(Params p_unused) {
    extern __shared__ __attribute__((aligned(16))) unsigned char lds_raw[];
    LAS unsigned char* lds = (LAS unsigned char*)lds_raw;
    cg::grid_group grid = cg::this_grid();
    int tidv = threadIdx.x;

    { IDS; KParams k = kp_get(); mods_phase(k->c, k->c_ctx, k->ada_w, k->ada_b, k->ws, lds, tid); }
    __syncthreads();
    { IDS; KParams k = kp_get(); conv_hgrn_weights(k->hg_w_in, k->hg_w_out, k->ws, 0, lds, GW, NGW_, wave, lane); }
    GSYNC();

    hgrn_pass<0, 0>(lds, lds_raw, grid, tidv); hgrn_pass<0, 1>(lds, lds_raw, grid, tidv);
    mla_layer<0>(lds, lds_raw, grid, tidv);
    hgrn_pass<1, 0>(lds, lds_raw, grid, tidv); hgrn_pass<1, 1>(lds, lds_raw, grid, tidv);
    mla_layer<1>(lds, lds_raw, grid, tidv);
}

extern "C" void kernel_launch(void* const* d_in, const int* in_sizes, int n_in, void* d_out, int out_size, void* d_ws, size_t ws_size, hipStream_t stream) {
    static int grid_blocks = 0;
    if (grid_blocks == 0) {
        if (n_in != 18 || ws_size < 512 * MiB) { fprintf(stderr, "kernel_launch: unexpected n_in %d / ws %zu\n", n_in, ws_size); grid_blocks = -1; return; }
        int dev = 0, cus = 0, per_cu = 0;
        hipGetDevice(&dev);
        hipDeviceGetAttribute(&cus, hipDeviceAttributeMultiprocessorCount, dev);
        if (hipFuncSetAttribute((const void*)mega_fwd, hipFuncAttributeMaxDynamicSharedMemorySize, LDS_BYTES) != hipSuccess) { fprintf(stderr, "kernel_launch: hipFuncSetAttribute failed\n"); grid_blocks = -1; return; }
        if (hipOccupancyMaxActiveBlocksPerMultiprocessor(&per_cu, (const void*)mega_fwd, 512, LDS_BYTES) != hipSuccess || per_cu < 1) { fprintf(stderr, "kernel_launch: occupancy query gave %d\n", per_cu); per_cu = 1; }
        (void)hipGetLastError();
        grid_blocks = cus * per_cu;
    }
    if (grid_blocks < 0) return;
    Params p{};
    p.x = (const float*)d_in[0]; p.c = (const float*)d_in[1]; p.ctx = (const float*)d_in[2]; p.c_ctx = (const float*)d_in[3];
    p.ada_w = (const float*)d_in[4]; p.ada_b = (const float*)d_in[5]; p.norm_pre = (const float*)d_in[6]; p.norm_post = (const float*)d_in[7];
    p.hg_w_in = (const float*)d_in[8]; p.hg_lb = (const float*)d_in[9]; p.hg_o_norm = (const float*)d_in[10]; p.hg_w_out = (const float*)d_in[11];
    p.mla_w_in = (const float*)d_in[12]; p.mla_qa_norm = (const float*)d_in[13]; p.mla_w_qb = (const float*)d_in[14]; p.mla_kva_norm = (const float*)d_in[15];
    p.mla_w_kvb = (const float*)d_in[16]; p.mla_w_out = (const float*)d_in[17];
    p.out = (float*)d_out; p.ws = (unsigned char*)d_ws;
    void* args[] = {&p};
    hipError_t e = hipLaunchCooperativeKernel((const void*)mega_fwd, dim3(grid_blocks), dim3(512), args, LDS_BYTES, stream);
    if (e != hipSuccess) fprintf(stderr, "kernel_launch: cooperative launch failed: %s (grid %d)\n", hipGetErrorString(e), grid_blocks);
}
```

```cpp
#include <hip/hip_runtime.h>
#include <hip/hip_cooperative_groups.h>
#include <cstdio>
#include <cstdint>
namespace cg = cooperative_groups;

#define LAS __attribute__((address_space(3)))
typedef unsigned short bf16_t;
typedef short bf16x8 __attribute__((ext_vector_type(8)));
typedef short s16x4 __attribute__((ext_vector_type(4)));
typedef float f32x4 __attribute__((ext_vector_type(4)));
typedef float f32x2 __attribute__((ext_vector_type(2)));
typedef float f32x16 __attribute__((ext_vector_type(16)));
typedef unsigned u32x4 __attribute__((ext_vector_type(4)));
typedef unsigned u32x2 __attribute__((ext_vector_type(2)));
typedef _Float16 h16x2 __attribute__((ext_vector_type(2)));

constexpr int NB = 8, LAT = 4096, CTXL = 256, TPB = LAT + CTXL  , T = NB * TPB  , TH = T / 2  ;
constexpr int DM = 1024, DI = 2048;
constexpr float EPS = 1e-6f;
constexpr float CQ = 0.07216878364870322f * 1.4426950408889634f;

constexpr size_t MiB = 1u << 20;
constexpr size_t WS_MODS = 64 * 1024;
constexpr size_t WS_TAB = 640 * 1024;
constexpr size_t WS_XCTX = 1 * MiB;
constexpr size_t WS_W = 9 * MiB;
constexpr size_t WS_HG_WIN = WS_W, WS_HG_WOUT = WS_W + 20 * MiB;
constexpr size_t WS_ML_WIN = WS_W, WS_ML_WQ = WS_W + 5 * MiB, WS_ML_WVB = WS_W + 7 * MiB, WS_ML_WOUT = WS_W + 8 * MiB;
constexpr size_t WS_ACT = 35 * MiB;
constexpr size_t HG_ARR = (size_t)TH * DI * 2;
constexpr size_t WS_HG_P = WS_ACT;
constexpr size_t WS_HG_OF = WS_ACT + 5 * HG_ARR, WS_HG_OB = WS_HG_OF + HG_ARR;
constexpr size_t WS_HG_H = WS_HG_OF;
constexpr size_t WS_HG_GATED = WS_HG_P;
constexpr size_t WS_HG_Y = WS_HG_P + HG_ARR;
constexpr size_t WS_ML_H = WS_ACT;
constexpr size_t WS_ML_QR = WS_ACT + 68 * MiB;
constexpr size_t WS_ML_Y = WS_ACT;
constexpr size_t WS_ML_SMALL = WS_ACT + 136 * MiB;
constexpr size_t WS_ML_QN = WS_ACT + 170 * MiB;
constexpr size_t WS_ML_KC = WS_ACT + 187 * MiB;
constexpr size_t WS_ML_Z = WS_ACT + 200 * MiB;
constexpr size_t WS_ML_QO = WS_ACT + 336 * MiB;
static_assert(WS_HG_OB + HG_ARR <= 512 * MiB && WS_ML_QO + 136 * MiB <= 512 * MiB, "ws map");

constexpr int LDS_BYTES = 147456;

typedef __bf16 bf16x2_t __attribute__((ext_vector_type(2)));
__device__ __forceinline__ unsigned cvt_pk_bf16(float lo, float hi) { f32x2 v = {lo, hi}; bf16x2_t b = __builtin_convertvector(v, bf16x2_t); return __builtin_bit_cast(unsigned, b); }
__device__ __forceinline__ unsigned f2bf(float f) { unsigned u = __builtin_bit_cast(unsigned, f); return (u + 0x7fffu + ((u >> 16) & 1u)) >> 16; }
__device__ __forceinline__ float bf2f(unsigned short b) { return __builtin_bit_cast(float, (unsigned)b << 16); }
__device__ __forceinline__ float bflo(unsigned w) { return __builtin_bit_cast(float, w << 16); }
__device__ __forceinline__ float bfhi(unsigned w) { return __builtin_bit_cast(float, w & 0xffff0000u); }
__device__ __forceinline__ unsigned pk_h2(float a, float b) { h16x2 v = {(_Float16)a, (_Float16)b}; return __builtin_bit_cast(unsigned, v); }
__device__ __forceinline__ float silu_f(float x) { return x * __builtin_amdgcn_rcpf(1.f + __expf(-x)); }
__device__ __forceinline__ int opaque_bid() { int b = blockIdx.x; asm volatile("" : "+s"(b)); return b; }
__device__ __forceinline__ int launder_s(int v) { asm volatile("" : "+s"(v)); return v; }
__device__ __forceinline__ int opaque_tid(int& tidv) { asm volatile("" : "+v"(tidv)); return tidv; }
__device__ __forceinline__ float shx(float v, int o, int lane) { return __builtin_bit_cast(float, __builtin_amdgcn_ds_bpermute((lane ^ o) << 2, __builtin_bit_cast(int, v))); }
__device__ __forceinline__ float wave_sum(float v, int lane) {
#pragma unroll
    for (int o = 1; o < 64; o <<= 1) v += shx(v, o, lane);
    return v;
}

namespace pg8 {
constexpr int BM = 256, BK = 64, HALF = 128, HTB = HALF * BK * 2, STAGE_BYTES = 8 * HTB, NXCD = 8, WGM = 8;
__host__ __device__ __forceinline__ int lds_byte(int r, int c) { const int st = (r >> 4) * 2 + (c >> 5), rr = r & 15, cc = c & 31, ob = rr * 64 + cc * 2; return st * 1024 + (ob ^ (((ob >> 9) & 1) << 5)); }
__host__ __device__ __forceinline__ void stage_rc(int b, int& R, int& C) { const int st = b / 1024, sb = b % 1024, swz = sb ^ (((sb >> 9) & 1) << 5); R = (st >> 1) * 16 + swz / 64; C = (st & 1) * 32 + (swz % 64) / 2; }
__host__ __device__ __forceinline__ int perm32(int rho) { const int n = rho >> 4, i = rho & 15; return 8 * (i >> 2) + 4 * n + (i & 3); }
struct Unit { int pm, pn; };
struct Gemm { const bf16_t* A; const bf16_t* Bt; int M, N, K, lda, ldb, acol_pn; };
struct StaticOrder {
    int nM, nN, nwg, G, c, skipctx;
    __device__ void init(int M, int N, int G_, int c_, int skipctx_ = 0) { nM = M / BM; if (skipctx_) nM = nM / 17 * 16; nN = N / BM; nwg = nM * nN; G = G_; c = c_; skipctx = skipctx_; }
    __device__ bool next(int i, Unit& u) const {
        const long L = (long)i * G + c; if (L >= nwg) return false;
        int wgid = (int)L; { const int q = nwg / NXCD, r = nwg % NXCD, xcd = wgid % NXCD, off = wgid / NXCD; wgid = (xcd < r ? xcd * (q + 1) : r * (q + 1) + (xcd - r) * q) + off; }
        const int nig = WGM * nN, gid = wgid / nig, fm = gid * WGM, gsz = (nM - fm) < WGM ? (nM - fm) : WGM;
        u.pm = fm + ((wgid % nig) % gsz); u.pn = (wgid % nig) / gsz; if (skipctx) u.pm = (u.pm >> 4) * 17 + 1 + (u.pm & 15); return true;
    }
};
template <class Epi>
__device__ __forceinline__ void gemm_phase(LAS unsigned char* lds, const Gemm g, const StaticOrder& S, const Epi& E, int& tidv) {
    const int tid = opaque_tid(tidv), wid = __builtin_amdgcn_readfirstlane(tid >> 6), lane = tid & 63, wr = wid >> 2, wc = wid & 3, fr = lane & 15, fq = lane >> 4;
    const int K = g.K, nt = K / BK;
    unsigned voffA[2], voffB[2];
#pragma unroll
    for (int i = 0; i < 2; ++i) { int R, C; stage_rc(tid * 16 + i * 8192, R, C); const int Rb = (R & ~31) + perm32(R & 31);
        voffA[i] = (unsigned)(R * g.lda + C) * 2u; voffB[i] = (unsigned)(Rb * g.ldb + C) * 2u; }
    const unsigned kstep = (unsigned)(BK * 2);
    const unsigned hA = (unsigned)HALF * (unsigned)g.lda * 2u, hB = (unsigned)HALF * (unsigned)g.ldb * 2u;
    const unsigned tA = 2u * hA, tB = 2u * hB;
    const unsigned ldsw = (unsigned)wid * 1024u;
    const int aoff = lds_byte(wr * 64 + fr, fq * 8), boff = lds_byte(wc * 32 + fr, fq * 8);
#define PG8_SA(b, h) (((b) * 2 + (h)) * HTB)
#define PG8_SB(b, h) ((4 + (b) * 2 + (h)) * HTB)
#define PG8_STAGE(bufoff, gbase, voff) do { _Pragma("unroll") for (int _i = 0; _i < 2; ++_i) \
        __builtin_amdgcn_global_load_lds((const unsigned*)((const char*)(gbase) + (voff)[_i]), (LAS unsigned*)(lds + (bufoff) + ldsw + _i * 8192), 16, 0, 0); } while (0)
#define PG8_LDA(dst, b, h) do { _Pragma("unroll") for (int m = 0; m < 4; ++m) _Pragma("unroll") for (int k = 0; k < 2; ++k) dst[m][k] = *(const LAS bf16x8*)(lds + PG8_SA(b, h) + aoff + m * 2048 + k * 1024); } while (0)
#define PG8_LDB(dst, b, h) do { _Pragma("unroll") for (int n = 0; n < 2; ++n) _Pragma("unroll") for (int k = 0; k < 2; ++k) dst[n][k] = *(const LAS bf16x8*)(lds + PG8_SB(b, h) + boff + n * 2048 + k * 1024); } while (0)
#define PG8_MMA(ai, bj, At, Bt) do { __builtin_amdgcn_s_setprio(1); _Pragma("unroll") for (int m = 0; m < 4; ++m) _Pragma("unroll") for (int n = 0; n < 2; ++n) _Pragma("unroll") for (int k = 0; k < 2; ++k) \
        acc[ai][bj][m][n] = __builtin_amdgcn_mfma_f32_16x16x32_bf16(Bt[n][k], At[m][k], acc[ai][bj][m][n], 0, 0, 0); __builtin_amdgcn_s_setprio(0); } while (0)
#define PG8_WAIT_V(n) asm volatile("s_waitcnt vmcnt(" #n ")" ::: "memory")
#define PG8_WAIT_L(n) asm volatile("s_waitcnt lgkmcnt(" #n ")" ::: "memory")
#define PG8_BAR __builtin_amdgcn_s_barrier()
#define PG8_SCHED __builtin_amdgcn_sched_barrier(0)
    Unit cur, nxt; int ui = 0;
    if (!S.next(0, cur)) return;
    f32x4 acc[2][2][4][2];
#pragma unroll
    for (int a = 0; a < 2; ++a)
#pragma unroll
        for (int b = 0; b < 2; ++b)
#pragma unroll
            for (int m = 0; m < 4; ++m)
#pragma unroll
                for (int n = 0; n < 2; ++n) acc[a][b][m][n] = (f32x4){0.f, 0.f, 0.f, 0.f};
    bf16x8 At[4][2], B0[2][2], B1[2][2];
    const char* cA = (const char*)g.A + (size_t)((unsigned)cur.pm * tA + (unsigned)(cur.pn * g.acol_pn * 2)); const char* cB = (const char*)g.Bt + (size_t)((unsigned)cur.pn * tB);
    PG8_STAGE(PG8_SB(0, 0), cB, voffB); PG8_STAGE(PG8_SB(0, 1), cB + hB, voffB); PG8_STAGE(PG8_SA(0, 0), cA, voffA); PG8_STAGE(PG8_SA(0, 1), cA + hA, voffA);
    if (wr == 1) PG8_BAR;
    PG8_WAIT_V(2); PG8_BAR;
    PG8_STAGE(PG8_SB(1, 0), cB + kstep, voffB); PG8_STAGE(PG8_SA(1, 0), cA + kstep, voffA); PG8_STAGE(PG8_SB(1, 1), cB + hB + kstep, voffB);
    PG8_WAIT_V(6); PG8_BAR;
    for (;;) {
        const bool has_next = S.next(ui + 1, nxt);
        const char* nA = has_next ? (const char*)g.A + (size_t)((unsigned)nxt.pm * tA + (unsigned)(nxt.pn * g.acol_pn * 2)) : cA; const char* nB = has_next ? (const char*)g.Bt + (size_t)((unsigned)nxt.pn * tB) : cB;
        for (int t = 0; t < nt; t += 2) {
            const bool last = (t == nt - 2);
            const char* a1 = cA + (unsigned)(t + 1) * kstep;
            const char* a2 = last ? nA : cA + (unsigned)(t + 2) * kstep; const char* b2 = last ? nB : cB + (unsigned)(t + 2) * kstep;
            const char* a3 = a2 + kstep; const char* b3 = b2 + kstep;
            PG8_LDB(B0, 0, 0); PG8_LDB(B1, 0, 1); PG8_SCHED; PG8_LDA(At, 0, 0); PG8_STAGE(PG8_SA(1, 1), a1 + hA, voffA);
            PG8_WAIT_V(8); PG8_WAIT_L(0); PG8_BAR; PG8_MMA(0, 0, At, B0); PG8_MMA(0, 1, At, B1); PG8_BAR; PG8_SCHED;
            PG8_LDA(At, 0, 1); PG8_STAGE(PG8_SB(0, 0), b2, voffB); PG8_STAGE(PG8_SB(0, 1), b2 + hB, voffB); PG8_STAGE(PG8_SA(0, 0), a2, voffA);
            PG8_WAIT_V(8); PG8_WAIT_L(0); PG8_BAR; PG8_MMA(1, 0, At, B0); PG8_MMA(1, 1, At, B1); PG8_BAR; PG8_SCHED;
            PG8_LDB(B0, 1, 0); PG8_LDB(B1, 1, 1); PG8_SCHED; PG8_LDA(At, 1, 0); PG8_STAGE(PG8_SA(0, 1), a2 + hA, voffA);
            PG8_WAIT_V(8); PG8_WAIT_L(0); PG8_BAR; PG8_MMA(0, 0, At, B0); PG8_MMA(0, 1, At, B1); PG8_BAR; PG8_SCHED;
            PG8_LDA(At, 1, 1); PG8_STAGE(PG8_SB(1, 0), b3, voffB); PG8_STAGE(PG8_SB(1, 1), b3 + hB, voffB); PG8_STAGE(PG8_SA(1, 0), a3, voffA);
            PG8_WAIT_V(8); PG8_WAIT_L(0); PG8_BAR; PG8_MMA(1, 0, At, B0); PG8_MMA(1, 1, At, B1); PG8_BAR; PG8_SCHED;
        }
        if (wr == 0) PG8_BAR;
        E(acc, cur, wr, wc, fr, fq);
        if (!has_next) break;
#pragma unroll
        for (int a = 0; a < 2; ++a)
#pragma unroll
            for (int b = 0; b < 2; ++b)
#pragma unroll
                for (int m = 0; m < 4; ++m)
#pragma unroll
                    for (int n = 0; n < 2; ++n) acc[a][b][m][n] = (f32x4){0.f, 0.f, 0.f, 0.f};
        cur = nxt; cA = nA; cB = nB; ++ui;
        if (wr == 1) PG8_BAR;
    }
    PG8_WAIT_V(0);
    PG8_BAR;
#undef PG8_SA
#undef PG8_SB
#undef PG8_STAGE
#undef PG8_LDA
#undef PG8_LDB
#undef PG8_MMA
#undef PG8_WAIT_V
#undef PG8_WAIT_L
#undef PG8_BAR
#undef PG8_SCHED
}

typedef f32x4 Acc[2][2][4][2];
struct EpiHgIn {
    bf16_t* base;
    __device__ __forceinline__ void operator()(const Acc& acc, const Unit& u, int wr, int wc, int fr, int fq) const {
        const int which = u.pn >> 3, colt = (u.pn & 7) * 256;
        bf16_t* ob = base + (size_t)which * ((size_t)TH * DI);
        const int row0 = u.pm * 256 + wr * 64 + fr, col0 = colt + wc * 32 + 8 * fq;
#pragma unroll
        for (int ai = 0; ai < 2; ++ai)
#pragma unroll
            for (int m = 0; m < 4; ++m) { bf16_t* rowp = ob + (size_t)(row0 + ai * 128 + m * 16) * DI + col0;
#pragma unroll
                for (int bj = 0; bj < 2; ++bj) { f32x4 v0 = acc[ai][bj][m][0], v1 = acc[ai][bj][m][1]; u32x4 w;
                    if (which == 0) {
#pragma unroll
                        for (int e = 0; e < 4; ++e) { v0[e] = silu_f(v0[e]); v1[e] = silu_f(v1[e]); } }
                    if (which == 2 || which == 3) { w.x = pk_h2(v0[0], v0[1]); w.y = pk_h2(v0[2], v0[3]); w.z = pk_h2(v1[0], v1[1]); w.w = pk_h2(v1[2], v1[3]); }
                    else { w.x = cvt_pk_bf16(v0[0], v0[1]); w.y = cvt_pk_bf16(v0[2], v0[3]); w.z = cvt_pk_bf16(v1[0], v1[1]); w.w = cvt_pk_bf16(v1[2], v1[3]); }
                    *(u32x4*)(rowp + bj * 128) = w; } }
    }
};
struct EpiF32 {
    bf16_t* out;
    __device__ __forceinline__ void operator()(const Acc& acc, const Unit& u, int wr, int wc, int fr, int fq) const {
        const int row0 = u.pm * 256 + wr * 64 + fr, col0 = u.pn * 256 + wc * 32 + 8 * fq;
#pragma unroll
        for (int ai = 0; ai < 2; ++ai)
#pragma unroll
            for (int m = 0; m < 4; ++m) { bf16_t* rowp = out + (size_t)(row0 + ai * 128 + m * 16) * DM + col0;
#pragma unroll
                for (int bj = 0; bj < 2; ++bj) { const f32x4 v0 = acc[ai][bj][m][0], v1 = acc[ai][bj][m][1]; u32x4 w;
                    w.x = cvt_pk_bf16(v0[0], v0[1]); w.y = cvt_pk_bf16(v0[2], v0[3]); w.z = cvt_pk_bf16(v1[0], v1[1]); w.w = cvt_pk_bf16(v1[2], v1[3]);
                    *(u32x4*)(rowp + bj * 128) = w; } }
    }
};
struct EpiMlaIn {
    bf16_t* small; bf16_t* z;
    __device__ __forceinline__ void operator()(const Acc& acc, const Unit& u, int wr, int wc, int fr, int fq) const {
        const bool sm = u.pn < 2; bf16_t* ob = sm ? small : z; const int ld = sm ? 512 : DI;
        const int row0 = u.pm * 256 + wr * 64 + fr, col0 = (sm ? u.pn : u.pn - 2) * 256 + wc * 32 + 8 * fq;
#pragma unroll
        for (int ai = 0; ai < 2; ++ai)
#pragma unroll
            for (int m = 0; m < 4; ++m) { bf16_t* rowp = ob + (size_t)(row0 + ai * 128 + m * 16) * ld + col0;
#pragma unroll
                for (int bj = 0; bj < 2; ++bj) { const f32x4 v0 = acc[ai][bj][m][0], v1 = acc[ai][bj][m][1]; u32x4 w;
                    w.x = cvt_pk_bf16(v0[0], v0[1]); w.y = cvt_pk_bf16(v0[2], v0[3]); w.z = cvt_pk_bf16(v1[0], v1[1]); w.w = cvt_pk_bf16(v1[2], v1[3]);
                    *(u32x4*)(rowp + bj * 128) = w; } }
    }
};
struct EpiQ {
    bf16_t* qn; bf16_t* qr;
    __device__ __forceinline__ void operator()(const Acc& acc, const Unit& u, int wr, int wc, int fr, int fq) const {
        const bool nope = u.pn < 8; bf16_t* ob = nope ? qn : qr; const int ld = nope ? DI : 1024;
        const int row0 = u.pm * 256 + wr * 64 + fr, col0 = (nope ? u.pn : u.pn - 8) * 256 + wc * 32 + 8 * fq;
#pragma unroll
        for (int ai = 0; ai < 2; ++ai)
#pragma unroll
            for (int m = 0; m < 4; ++m) { bf16_t* rowp = ob + (size_t)(row0 + ai * 128 + m * 16) * ld + col0;
#pragma unroll
                for (int bj = 0; bj < 2; ++bj) { const f32x4 v0 = acc[ai][bj][m][0] * CQ, v1 = acc[ai][bj][m][1] * CQ; u32x4 w;
                    w.x = cvt_pk_bf16(v0[0], v0[1]); w.y = cvt_pk_bf16(v0[2], v0[3]); w.z = cvt_pk_bf16(v1[0], v1[1]); w.w = cvt_pk_bf16(v1[2], v1[3]);
                    *(u32x4*)(rowp + bj * 128) = w; } }
    }
};
struct EpiVb {
    bf16_t* out; const bf16_t* z;
    __device__ __forceinline__ void operator()(const Acc& acc, const Unit& u, int wr, int wc, int fr, int fq) const {
        const int row0 = u.pm * 256 + wr * 64 + fr, col0 = u.pn * 256 + wc * 32 + 8 * fq;
#pragma unroll
        for (int ai = 0; ai < 2; ++ai)
#pragma unroll
            for (int m = 0; m < 4; ++m) { const size_t off = (size_t)(row0 + ai * 128 + m * 16) * DI + col0;
#pragma unroll
                for (int bj = 0; bj < 2; ++bj) { const f32x4 v0 = acc[ai][bj][m][0], v1 = acc[ai][bj][m][1]; const u32x4 zz = *(const u32x4*)(z + off + bj * 128); u32x4 w;
                    w.x = cvt_pk_bf16(v0[0] * silu_f(bflo(zz.x)), v0[1] * silu_f(bfhi(zz.x))); w.y = cvt_pk_bf16(v0[2] * silu_f(bflo(zz.y)), v0[3] * silu_f(bfhi(zz.y)));
                    w.z = cvt_pk_bf16(v1[0] * silu_f(bflo(zz.z)), v1[1] * silu_f(bfhi(zz.z))); w.w = cvt_pk_bf16(v1[2] * silu_f(bflo(zz.w)), v1[3] * silu_f(bfhi(zz.w)));
                    *(u32x4*)(out + off + bj * 128) = w; } }
    }
};
}

namespace att {
constexpr int NW = 8, QBLK = 32, KVBLK = 64;
constexpr int SHM_V = 16384, SHM_KN = 16384, SHM_KR = 8192;
constexpr int NBUF = 3, OFF_V = 0, OFF_KN = NBUF * SHM_V, OFF_KR = OFF_KN + NBUF * SHM_KN, OFF_WS = OFF_KR + NBUF * SHM_KR, SHM_ATTN = OFF_WS + NW * 64 * 4;
static_assert(SHM_ATTN <= 131072, "attention LDS");
constexpr float THR2 = 11.0f;
#define KSWZ(row, colB) ((row) * 256 + ((colB) ^ (((row) & 15) << 4)))
#define KRSWZ(row, colB) ((row) * 128 + ((colB) ^ ((((row) >> 1) & 7) << 4)))
#define SBAR() __builtin_amdgcn_sched_barrier(0)
__device__ __forceinline__ int crow(int r, int hi) { return (r & 3) + 8 * (r >> 2) + 4 * hi; }
__device__ __forceinline__ void partialSM(f32x16& p0, f32x16& p1, float& m_reg, float& mn, float& alpha) {
    float pmax = p0[0];
#pragma unroll
    for (int r = 1; r < 16; ++r) pmax = fmaxf(pmax, p0[r]);
#pragma unroll
    for (int r = 0; r < 16; ++r) pmax = fmaxf(pmax, p1[r]);
    { auto rr = __builtin_amdgcn_permlane32_swap(__float_as_uint(pmax), __float_as_uint(pmax), false, false);
      pmax = fmaxf(__uint_as_float(rr[0]), __uint_as_float(rr[1])); }
    if (__builtin_expect(__all(pmax - m_reg <= THR2), 1)) { mn = m_reg; alpha = 1.f; }
    else { mn = fmaxf(m_reg, pmax); alpha = __builtin_amdgcn_exp2f(m_reg - mn); m_reg = mn; }
#pragma unroll
    for (int r = 0; r < 16; ++r) p0[r] = p0[r] - mn;
#pragma unroll
    for (int r = 0; r < 16; ++r) p1[r] = p1[r] - mn;
#pragma unroll
    for (int r = 0; r < 16; ++r) p0[r] = __builtin_amdgcn_exp2f(p0[r]);
}
__device__ __forceinline__ void finishSM(f32x16& p0, f32x16& p1, float alpha, float& l_reg, bf16x8& pa0, bf16x8& pa1, bf16x8& pa2, bf16x8& pa3) {
#pragma unroll
    for (int r = 0; r < 16; ++r) p1[r] = __builtin_amdgcn_exp2f(p1[r]);
    float ps = 0;
#pragma unroll
    for (int r = 0; r < 16; ++r) ps += p0[r];
#pragma unroll
    for (int r = 0; r < 16; ++r) ps += p1[r];
    { auto rr = __builtin_amdgcn_permlane32_swap(__float_as_uint(ps), __float_as_uint(ps), false, false);
      ps = __uint_as_float(rr[0]) + __uint_as_float(rr[1]); }
    l_reg = l_reg * alpha + ps;
#define PK4(P, BASE, OUT) do { unsigned a0 = cvt_pk_bf16(P[BASE + 0], P[BASE + 1]), a1 = cvt_pk_bf16(P[BASE + 2], P[BASE + 3]);   \
    unsigned b0 = cvt_pk_bf16(P[BASE + 4], P[BASE + 5]), b1 = cvt_pk_bf16(P[BASE + 6], P[BASE + 7]);                              \
    auto r0 = __builtin_amdgcn_permlane32_swap(a0, b0, false, false); auto r1 = __builtin_amdgcn_permlane32_swap(a1, b1, false, false); \
    u32x4 w = {r0[0], r1[0], r0[1], r1[1]}; OUT = *reinterpret_cast<bf16x8*>(&w); } while (0)
    PK4(p0, 0, pa0); PK4(p0, 8, pa1); PK4(p1, 0, pa2); PK4(p1, 8, pa3);
#undef PK4
}
__device__ __forceinline__ void qkt(f32x16& p0, f32x16& p1, const char* Kn, const char* Kr, const bf16x8* qr, int r32, int hi) {
    p0 = f32x16{}; p1 = f32x16{};
#pragma unroll
    for (int d0 = 0; d0 < 8; ++d0) { const int cb = (d0 * 16 + hi * 8) * 2;
        const bf16x8 b0 = *reinterpret_cast<const bf16x8*>(Kn + KSWZ(r32, cb));
        const bf16x8 b1 = *reinterpret_cast<const bf16x8*>(Kn + KSWZ(32 + r32, cb));
        p0 = __builtin_amdgcn_mfma_f32_32x32x16_bf16(b0, qr[d0], p0, 0, 0, 0);
        p1 = __builtin_amdgcn_mfma_f32_32x32x16_bf16(b1, qr[d0], p1, 0, 0, 0); }
#pragma unroll
    for (int d0 = 0; d0 < 4; ++d0) { const int cb = (d0 * 16 + hi * 8) * 2;
        const bf16x8 b0 = *reinterpret_cast<const bf16x8*>(Kr + KRSWZ(r32, cb));
        const bf16x8 b1 = *reinterpret_cast<const bf16x8*>(Kr + KRSWZ(32 + r32, cb));
        p0 = __builtin_amdgcn_mfma_f32_32x32x16_bf16(b0, qr[8 + d0], p0, 0, 0, 0);
        p1 = __builtin_amdgcn_mfma_f32_32x32x16_bf16(b1, qr[8 + d0], p1, 0, 0, 0); }
}
__device__ __forceinline__ int v_st(int k, int c) { const int kk = (k & ~0xC) | ((k & 4) << 1) | ((k & 8) >> 1); return ((kk >> 3) * 4 + (c >> 5)) * 512 + ((kk & 7) * 32 + (c & 31)) * 2; }
__device__ __forceinline__ int v_rd_base(int lane) { return ((lane & 3) << 3) | (((lane >> 2) & 3) << 6) | (((lane >> 4) & 1) << 5) | (((lane >> 5) & 1) << 8); }
constexpr int v_rd_off(int d0, int ks, int half) { return d0 * 512 + ks * 4096 + half * 2048; }
template <int OFF> __device__ __forceinline__ s16x4 tr_read(int vb) {
    s16x4 r; asm volatile("ds_read_b64_tr_b16 %0, %1 offset:%2" : "=&v"(r) : "v"(vb), "i"(OFF) : "memory"); return r;
}
template <int D0> __device__ __forceinline__ void pv_one(f32x16& od, int vb, bf16x8 pa0, bf16x8 pa1, bf16x8 pa2, bf16x8 pa3) {
    const s16x4 l0 = tr_read<v_rd_off(D0, 0, 0)>(vb), h0 = tr_read<v_rd_off(D0, 0, 1)>(vb), l1 = tr_read<v_rd_off(D0, 1, 0)>(vb), h1 = tr_read<v_rd_off(D0, 1, 1)>(vb);
    const s16x4 l2 = tr_read<v_rd_off(D0, 2, 0)>(vb), h2 = tr_read<v_rd_off(D0, 2, 1)>(vb), l3 = tr_read<v_rd_off(D0, 3, 0)>(vb), h3 = tr_read<v_rd_off(D0, 3, 1)>(vb);
    asm volatile("s_waitcnt lgkmcnt(0)" ::: "memory"); SBAR();
#define PK(L, H) (bf16x8){L[0], L[1], L[2], L[3], H[0], H[1], H[2], H[3]}
    od = __builtin_amdgcn_mfma_f32_32x32x16_bf16(pa0, PK(l0, h0), od, 0, 0, 0);
    od = __builtin_amdgcn_mfma_f32_32x32x16_bf16(pa1, PK(l1, h1), od, 0, 0, 0);
    od = __builtin_amdgcn_mfma_f32_32x32x16_bf16(pa2, PK(l2, h2), od, 0, 0, 0);
    od = __builtin_amdgcn_mfma_f32_32x32x16_bf16(pa3, PK(l3, h3), od, 0, 0, 0);
#undef PK
}
__device__ __forceinline__ void pv_d0(f32x16* o, int vb, bf16x8 pa0, bf16x8 pa1, bf16x8 pa2, bf16x8 pa3) {
    pv_one<0>(o[0], vb, pa0, pa1, pa2, pa3); pv_one<1>(o[1], vb, pa0, pa1, pa2, pa3); pv_one<2>(o[2], vb, pa0, pa1, pa2, pa3); pv_one<3>(o[3], vb, pa0, pa1, pa2, pa3);
}
__device__ __forceinline__ void attn_unit(const bf16_t* Qn, const bf16_t* Qr, const bf16_t* __restrict__ Kh, bf16_t* Ob, int seq, char* lds, int tq0  , const float* tab, const bf16_t* __restrict__ Wv  , const bf16_t* __restrict__ Zr  , int& tidv) {
    const int tid = opaque_tid(tidv), wid = tid >> 6, lane = tid & 63, r32 = lane & 31, hi = lane >> 5;
    char* V_lds = lds + OFF_V; char* KN_lds = lds + OFF_KN; char* KR_lds = lds + OFF_KR;
    float* ws = (float*)(lds + OFF_WS) + wid * 64; float* li_l = ws; float* al_l = ws + 32;
    float m_reg = -1e30f, l_reg = 0; f32x16 o[4] = {}; bf16x8 qr[12];
    { const bf16_t* Qw = Qn + (long)(wid * QBLK + r32) * DI + hi * 8;
#pragma unroll
      for (int d0 = 0; d0 < 8; ++d0) qr[d0] = *reinterpret_cast<const bf16x8*>(Qw + d0 * 16);
      const bf16_t* Qw2 = Qr + (long)(wid * QBLK + r32) * 1024 + hi * 8;
#pragma unroll
      for (int d0 = 0; d0 < 4; ++d0) qr[8 + d0] = *reinterpret_cast<const bf16x8*>(Qw2 + d0 * 16);
      if (tq0 >= 0) { const int t = tq0 + wid * QBLK + r32;
#pragma unroll
        for (int d0 = 0; d0 < 4; ++d0) { const int pos = d0 < 2 ? (t >> 6) : (t & 63); const float* tp = tab + (pos * 16 + (d0 & 1) * 8 + hi * 4) * 2;
            const f32x4 c0 = *(const f32x4*)tp, c1 = *(const f32x4*)(tp + 4); const u32x4 q = __builtin_bit_cast(u32x4, qr[8 + d0]); u32x4 w;
            { const float a = bflo(q.x), b = bfhi(q.x); w.x = cvt_pk_bf16(a * c0[0] - b * c0[1], a * c0[1] + b * c0[0]); }
            { const float a = bflo(q.y), b = bfhi(q.y); w.y = cvt_pk_bf16(a * c0[2] - b * c0[3], a * c0[3] + b * c0[2]); }
            { const float a = bflo(q.z), b = bfhi(q.z); w.z = cvt_pk_bf16(a * c1[0] - b * c1[1], a * c1[1] + b * c1[0]); }
            { const float a = bflo(q.w), b = bfhi(q.w); w.w = cvt_pk_bf16(a * c1[2] - b * c1[3], a * c1[3] + b * c1[2]); }
            qr[8 + d0] = __builtin_bit_cast(bf16x8, w); } } }
    const int sr = tid >> 4, sc = (tid & 15) * 8, vst0 = v_st(sr, sc), vst1 = v_st(32 + sr, sc);
    const int rr_ = tid >> 3, rc = (tid & 7) * 8;
    const int vb0 = (int)(uintptr_t)V_lds + v_rd_base(lane);
    struct { bf16x8 ks0, ks1, kr; } sr_[1];
#define SLOAD(i, k0) do { sr_[i].ks0 = *reinterpret_cast<const bf16x8*>(&Kh[(long)((k0) + sr) * 192 + sc]); sr_[i].ks1 = *reinterpret_cast<const bf16x8*>(&Kh[(long)((k0) + 32 + sr) * 192 + sc]); \
    sr_[i].kr = *reinterpret_cast<const bf16x8*>(&Kh[(long)((k0) + rr_) * 192 + 128 + rc]); } while (0)
#define SWRITE(b, i) do { *(bf16x8*)(V_lds + (b) * SHM_V + vst0) = sr_[i].ks0; *(bf16x8*)(V_lds + (b) * SHM_V + vst1) = sr_[i].ks1; const int kc = sc * 2; \
    *(bf16x8*)(KN_lds + (b) * SHM_KN + KSWZ(sr, kc)) = sr_[i].ks0; *(bf16x8*)(KN_lds + (b) * SHM_KN + KSWZ(32 + sr, kc)) = sr_[i].ks1; \
    *(bf16x8*)(KR_lds + (b) * SHM_KR + KRSWZ(rr_, rc * 2)) = sr_[i].kr; } while (0)
#define SWAIT() asm volatile("s_waitcnt vmcnt(0)" ::: "memory")
#define RESC(a) do { if (__any((a) < 1.f)) { if (hi == 0) al_l[r32] = (a); asm volatile("s_waitcnt lgkmcnt(0)" ::: "memory"); \
    _Pragma("unroll") for (int d = 0; d < 4; ++d) _Pragma("unroll") for (int r = 0; r < 16; ++r) o[d][r] *= al_l[crow(r, hi)]; } } while (0)
    f32x16 pA0, pA1, pB0, pB1; float mnA, mnB, alA, alB; bf16x8 pa0, pa1, pa2, pa3; const int NT = seq / KVBLK;
    SLOAD(0, 0); asm volatile("s_waitcnt vmcnt(0)" ::: "memory"); SWRITE(0, 0); __syncthreads();
    qkt(pA0, pA1, KN_lds, KR_lds, qr, r32, hi); partialSM(pA0, pA1, m_reg, mnA, alA);
    SLOAD(0, KVBLK);
    SWAIT(); SWRITE(1, 0); if (2 < NT) SLOAD(0, 2 * KVBLK); __syncthreads();
    int bp = 0, bc = 1, bn = 2;
#define ROT3() do { bp = bc; bc = bn; bn = (bn == NBUF - 1) ? 0 : bn + 1; } while (0)
    for (int t = 1; t + 1 < NT; t += 2) {
        SBAR(); qkt(pB0, pB1, KN_lds + bc * SHM_KN, KR_lds + bc * SHM_KR, qr, r32, hi);
        finishSM(pA0, pA1, alA, l_reg, pa0, pa1, pa2, pa3); SBAR();
        pv_d0(o, vb0 + bp * SHM_V, pa0, pa1, pa2, pa3); partialSM(pB0, pB1, m_reg, mnB, alB);
        SWAIT(); SWRITE(bn, 0); SBAR();
        if (t + 2 < NT) SLOAD(0, (t + 2) * KVBLK); SBAR();
        RESC(alB); __syncthreads(); ROT3();
        SBAR(); qkt(pA0, pA1, KN_lds + bc * SHM_KN, KR_lds + bc * SHM_KR, qr, r32, hi);
        finishSM(pB0, pB1, alB, l_reg, pa0, pa1, pa2, pa3); SBAR();
        pv_d0(o, vb0 + bp * SHM_V, pa0, pa1, pa2, pa3); partialSM(pA0, pA1, m_reg, mnA, alA);
        if (t + 2 < NT) { SWAIT(); SWRITE(bn, 0); } SBAR();
        if (t + 3 < NT) SLOAD(0, (t + 3) * KVBLK); SBAR();
        RESC(alA); __syncthreads(); ROT3();
    }
    SBAR(); qkt(pB0, pB1, KN_lds + bc * SHM_KN, KR_lds + bc * SHM_KR, qr, r32, hi);
    finishSM(pA0, pA1, alA, l_reg, pa0, pa1, pa2, pa3); SBAR();
    pv_d0(o, vb0 + bp * SHM_V, pa0, pa1, pa2, pa3); partialSM(pB0, pB1, m_reg, mnB, alB);
    RESC(alB);
    finishSM(pB0, pB1, alB, l_reg, pa0, pa1, pa2, pa3); SBAR();
    pv_d0(o, vb0 + bc * SHM_V, pa0, pa1, pa2, pa3);
#undef ROT3
    if (hi == 0) li_l[r32] = l_reg; asm volatile("s_waitcnt lgkmcnt(0)" ::: "memory");
    float rli[16];
#pragma unroll
    for (int r = 0; r < 16; ++r) rli[r] = __builtin_amdgcn_rcpf(li_l[crow(r, hi)]);
    const int wv_row = tid >> 2, wv_c4 = (tid & 3) * 32; const u32x4* wv_src = (const u32x4*)(Wv + (size_t)wv_row * 128 + wv_c4);
    const u32x4 wv0 = wv_src[0], wv1 = wv_src[1], wv2 = wv_src[2], wv3 = wv_src[3];
    __syncthreads();
    { char* dst = lds + wv_row * 272 + wv_c4 * 2;
      *(u32x4*)dst = wv0; *(u32x4*)(dst + 16) = wv1; *(u32x4*)(dst + 32) = wv2; *(u32x4*)(dst + 48) = wv3; }
    char* os = lds + 34816 + wid * 8704;
#pragma unroll
    for (int r = 0; r < 16; ++r) { const int orow = crow(r, hi);
#pragma unroll
        for (int d0 = 0; d0 < 4; ++d0) *(bf16_t*)(os + orow * 272 + (d0 * 32 + r32) * 2) = (bf16_t)f2bf(o[d0][r] * rli[r]); }
    __syncthreads();
    f32x16 gacc[4] = {};
#pragma unroll
    for (int ks = 0; ks < 8; ++ks) { const bf16x8 A = *reinterpret_cast<const bf16x8*>(os + r32 * 272 + (ks * 16 + hi * 8) * 2);
#pragma unroll
        for (int nb = 0; nb < 4; ++nb) { const bf16x8 Bv = *reinterpret_cast<const bf16x8*>(lds + (nb * 32 + r32) * 272 + (ks * 16 + hi * 8) * 2);
            gacc[nb] = __builtin_amdgcn_mfma_f32_32x32x16_bf16(A, Bv, gacc[nb], 0, 0, 0); } }
#pragma unroll
    for (int r = 0; r < 16; ++r) { const int orow = crow(r, hi);
#pragma unroll
        for (int nb = 0; nb < 4; ++nb) *(bf16_t*)(os + orow * 272 + (nb * 32 + r32) * 2) = (bf16_t)(cvt_pk_bf16(gacc[nb][r], 0.f) & 0xffffu); }
    bf16_t* Ow = Ob + (long)(wid * QBLK) * DI; const bf16_t* Zw = Zr + (long)(wid * QBLK) * DI;
#pragma unroll
    for (int i = 0; i < 8; ++i) { const int row = i * 4 + (lane >> 4), ch = lane & 15;
        const u32x4 v = *reinterpret_cast<const u32x4*>(os + row * 272 + ch * 16); const u32x4 zz = *(const u32x4*)(Zw + (long)row * DI + ch * 8); u32x4 w;
        w.x = cvt_pk_bf16(bflo(v.x) * silu_f(bflo(zz.x)), bfhi(v.x) * silu_f(bfhi(zz.x))); w.y = cvt_pk_bf16(bflo(v.y) * silu_f(bflo(zz.y)), bfhi(v.y) * silu_f(bfhi(zz.y)));
        w.z = cvt_pk_bf16(bflo(v.z) * silu_f(bflo(zz.z)), bfhi(v.z) * silu_f(bfhi(zz.z))); w.w = cvt_pk_bf16(bflo(v.w) * silu_f(bflo(zz.w)), bfhi(v.w) * silu_f(bfhi(zz.w)));
        *(u32x4*)(Ow + (long)row * DI + ch * 8) = w; }
    __syncthreads();
#undef SLOAD
#undef SWRITE
#undef SWAIT
#undef RESC
}
}

struct Params {
    const float *x, *c, *ctx, *c_ctx, *ada_w, *ada_b, *norm_pre, *norm_post, *hg_w_in, *hg_lb, *hg_o_norm, *hg_w_out,
                *mla_w_in, *mla_qa_norm, *mla_w_qb, *mla_kva_norm, *mla_w_kvb, *mla_w_out;
    float* out; unsigned char* ws;
};

__device__ __forceinline__ void transpose_item(const float* W, int ldw, int src_n0, int k0, bf16_t* WT, int ldt, int dst_row0, LAS float* scr, int lane) {
    f32x4 v[8];
#pragma unroll
    for (int i = 0; i < 8; ++i) { const int kk = 8 * i + (lane >> 3); v[i] = src_n0 >= 0 ? *(const f32x4*)(W + (size_t)(k0 + kk) * ldw + src_n0 + (lane & 7) * 4) : (f32x4){0.f, 0.f, 0.f, 0.f}; }
#pragma unroll
    for (int i = 0; i < 8; ++i) { const int kk = 8 * i + (lane >> 3); LAS float* d = scr + kk * 33 + (lane & 7) * 4; d[0] = v[i][0]; d[1] = v[i][1]; d[2] = v[i][2]; d[3] = v[i][3]; }
    asm volatile("s_waitcnt lgkmcnt(0)" ::: "memory");
    const int c = lane & 7;
#pragma unroll
    for (int j = 0; j < 4; ++j) { const int n = (lane >> 3) + 8 * j; const LAS float* s = scr + (8 * c) * 33 + n;
        u32x4 o; o.x = cvt_pk_bf16(s[0 * 33], s[1 * 33]); o.y = cvt_pk_bf16(s[2 * 33], s[3 * 33]); o.z = cvt_pk_bf16(s[4 * 33], s[5 * 33]); o.w = cvt_pk_bf16(s[6 * 33], s[7 * 33]);
        *(u32x4*)(WT + (size_t)(dst_row0 + n) * ldt + k0 + 8 * c) = o; }
    asm volatile("s_waitcnt lgkmcnt(0)" ::: "memory");
}
__device__ __forceinline__ void conv_hgrn_weights(const float* hg_w_in, const float* hg_w_out, unsigned char* ws, int j, LAS unsigned char* lds, int gw, int NGW, int wave, int lane) {
    LAS float* scr = (LAS float*)(lds + wave * 16384);
    const float* win = hg_w_in + (size_t)j * DM * 10240; const float* wout = hg_w_out + (size_t)j * DI * DM;
    bf16_t* win_t = (bf16_t*)(ws + WS_HG_WIN); bf16_t* wout_t = (bf16_t*)(ws + WS_HG_WOUT);
    constexpr int I_IN = 16 * 320, I_OUT = 32 * 32;
    for (int it = gw; it < I_IN + I_OUT; it += NGW) {
        if (it < I_IN) { const int kb = it / 320, nb = it % 320; transpose_item(win, 10240, nb * 32, kb * 64, win_t, DM, nb * 32, scr, lane); }
        else { const int r = it - I_IN, kb = r / 32, nb = r % 32; transpose_item(wout, DM, nb * 32, kb * 64, wout_t, DI, nb * 32, scr, lane); }
    }
}
__device__ __forceinline__ void conv_mla_weights(const float* mla_w_in, const float* mla_w_out, const float* mla_w_qb, const float* mla_w_kvb, unsigned char* ws, int j, LAS unsigned char* lds, int gw, int NGW, int wave, int lane) {
    LAS float* scr = (LAS float*)(lds + wave * 16384);
    const float* win = mla_w_in + (size_t)j * DM * 2496; const float* wout = mla_w_out + (size_t)j * DI * DM;
    const float* wqb = mla_w_qb + (size_t)j * 256 * 3072; const float* wkvb = mla_w_kvb + (size_t)j * 128 * 4096;
    bf16_t* win_t = (bf16_t*)(ws + WS_ML_WIN); bf16_t* wout_t = (bf16_t*)(ws + WS_ML_WOUT);
    bf16_t* wq_t = (bf16_t*)(ws + WS_ML_WQ); bf16_t* wvb_t = (bf16_t*)(ws + WS_ML_WVB);
    constexpr int I_IN = 16 * 80, I_OUT = 32 * 32;
    for (int it = gw; it < I_IN + I_OUT; it += NGW) {
        if (it < I_IN) { const int kb = it / 80, nb = it % 80; const int src = nb < 14 ? nb * 32 : (nb < 16 ? -1 : nb * 32 - 64);
            transpose_item(win, 2496, src, kb * 64, win_t, DM, nb * 32, scr, lane); }
        else { const int r = it - I_IN, kb = r / 32, nb = r % 32; transpose_item(wout, DM, nb * 32, kb * 64, wout_t, DI, nb * 32, scr, lane); }
    }
    const int gt = gw * 64 + lane, NGT = NGW * 64;
    for (int idx = gt; idx < 2048 * 64; idx += NGT) { const int r0 = (idx & 63) * 4, n = idx >> 6, h = n >> 7, c = n & 127;
        const f32x4* kv = (const f32x4*)(wkvb + (size_t)c * 4096 + h * 256); float a[4] = {0.f, 0.f, 0.f, 0.f};
        for (int d4 = 0; d4 < 32; ++d4) { const f32x4 kk = kv[d4];
#pragma unroll
            for (int e = 0; e < 4; ++e) { const f32x4 q = *(const f32x4*)(wqb + (size_t)(r0 + e) * 3072 + h * 192 + d4 * 4); a[e] += q[0] * kk[0] + q[1] * kk[1] + q[2] * kk[2] + q[3] * kk[3]; } }
        u32x2 w; w.x = cvt_pk_bf16(a[0], a[1]); w.y = cvt_pk_bf16(a[2], a[3]); *(u32x2*)(wq_t + (size_t)n * 256 + r0) = w; }
    for (int idx = gt; idx < 1024 * 64; idx += NGT) { const int r0 = (idx & 63) * 4, nn = idx >> 6, h = nn >> 6, jj = (nn & 63) >> 1, e = nn & 1; const int col = h * 192 + 128 + jj + 32 * e;
        u32x2 w; w.x = cvt_pk_bf16(wqb[(size_t)r0 * 3072 + col], wqb[(size_t)(r0 + 1) * 3072 + col]); w.y = cvt_pk_bf16(wqb[(size_t)(r0 + 2) * 3072 + col], wqb[(size_t)(r0 + 3) * 3072 + col]);
        *(u32x2*)(wq_t + (size_t)(2048 + nn) * 256 + r0) = w; }
    for (int idx = gt; idx < 2048 * 32; idx += NGT) { const int k0 = (idx & 31) * 4, hn = idx >> 5, h = hn >> 7, n = hn & 127; const int col = h * 256 + 128 + n;
        u32x2 w; w.x = cvt_pk_bf16(wkvb[(size_t)k0 * 4096 + col], wkvb[(size_t)(k0 + 1) * 4096 + col]); w.y = cvt_pk_bf16(wkvb[(size_t)(k0 + 2) * 4096 + col], wkvb[(size_t)(k0 + 3) * 4096 + col]);
        *(u32x2*)(wvb_t + (size_t)hn * 128 + k0) = w; }
}
__device__ __forceinline__ void mods_phase(const float* pc, const float* pcc, const float* ada_w, const float* ada_b, unsigned char* ws, LAS unsigned char* lds, int tid) {
    LAS float* sc = (LAS float*)lds;
    LAS float* red = (LAS float*)(lds + 36864);
    for (int i = tid; i < 9 * 1024; i += 512) { const float v = i < 8192 ? pc[i] : pcc[i - 8192]; sc[i] = silu_f(v); }
    __syncthreads();
    float* mods = (float*)(ws + WS_MODS);
    const int col = tid % 48, kg = tid / 48;
    for (int item = blockIdx.x; item < 4 * 64; item += gridDim.x) {
        const int layer = item >> 6, n0 = (item & 63) * 48;
        if (kg < 10) {
            const float* w = ada_w + (size_t)layer * DM * 3072 + n0 + col;
            float a[9];
#pragma unroll
            for (int q = 0; q < 9; ++q) a[q] = 0.f;
#pragma unroll 16
            for (int k = kg; k < DM; k += 10) { const float wv = w[(size_t)k * 3072];
#pragma unroll
                for (int q = 0; q < 9; ++q) a[q] += sc[q * 1024 + k] * wv; }
#pragma unroll
            for (int q = 0; q < 9; ++q) red[(kg * 9 + q) * 48 + col] = a[q];
        }
        __syncthreads();
        if (tid < 432) { const int q = tid / 48, cc = tid % 48; float s = 0.f;
#pragma unroll
            for (int g = 0; g < 10; ++g) s += red[(g * 9 + q) * 48 + cc];
            mods[((size_t)layer * 9 + q) * 3072 + n0 + cc] = s + ada_b[layer * 3072 + n0 + cc]; }
        __syncthreads();
    }
    if (blockIdx.x == gridDim.x - 1) { float* tab = (float*)(ws + WS_TAB);
        for (int i = tid; i < 1024; i += 512) { const int pos = i >> 4, m = i & 15; const float inv = __builtin_amdgcn_exp2f(-(float)m * (13.287712379549449f / 16.f)); const float ang = (float)pos * inv;
            tab[2 * i] = __cosf(ang); tab[2 * i + 1] = __sinf(ang); } }
}
__device__ __forceinline__ void row_info(int r, int& b, int& i) { b = r / TPB; i = r - b * TPB; }
__device__ __forceinline__ void pre_rows(const float* lat, const float* ctx, const float* mods_l, const float* npre, bf16_t* H, int r0, int r1, int gw, int NGW, int lane) {
    for (int r = r0 + gw; r < r1; r += NGW) { int b, i; row_info(r, b, i);
        const float* xr = i < CTXL ? ctx + (size_t)(b * CTXL + i) * DM : lat + (size_t)(b * LAT + i - CTXL) * DM;
        const float* mod = mods_l + (size_t)(i < CTXL ? 8 : b) * 3072;
        f32x4 v[4]; float ss = 0.f;
#pragma unroll
        for (int q = 0; q < 4; ++q) { v[q] = *(const f32x4*)(xr + 4 * lane + 256 * q); ss += (v[q].x * v[q].x + v[q].y * v[q].y) + (v[q].z * v[q].z + v[q].w * v[q].w); }
        const float rstd = __builtin_amdgcn_rsqf(wave_sum(ss, lane) * (1.f / DM) + EPS);
        bf16_t* hr = H + (size_t)(r - r0) * DM;
#pragma unroll
        for (int q = 0; q < 4; ++q) { const int cc = 4 * lane + 256 * q; const f32x4 g = *(const f32x4*)(npre + cc), sh = *(const f32x4*)(mod + cc), sc = *(const f32x4*)(mod + 1024 + cc);
            const f32x4 h = v[q] * rstd * g * (sc + 1.f) + sh; u32x2 w; w.x = cvt_pk_bf16(h.x, h.y); w.y = cvt_pk_bf16(h.z, h.w); *(u32x2*)(hr + cc) = w; } }
}
__device__ __forceinline__ void post_rows(const float* slat, const float* sctx, float* dlat, float* dctx, const float* Y, const float* mods_l, const float* npost, int r0, int r1, bool write_ctx, int gw, int NGW, int lane) {
    for (int r = r0 + gw; r < r1; r += NGW) { int b, i; row_info(r, b, i);
        if (i < CTXL && !write_ctx) continue;
        const size_t off = i < CTXL ? (size_t)(b * CTXL + i) * DM : (size_t)(b * LAT + i - CTXL) * DM;
        const float* xr = (i < CTXL ? sctx : slat) + off; float* dr = (i < CTXL ? dctx : dlat) + off;
        const float* mod = mods_l + (size_t)(i < CTXL ? 8 : b) * 3072 + 2048;
        const float* yr = Y + (size_t)(r - r0) * DM;
        f32x4 v[4]; float ss = 0.f;
#pragma unroll
        for (int q = 0; q < 4; ++q) { v[q] = *(const f32x4*)(yr + 4 * lane + 256 * q); ss += (v[q].x * v[q].x + v[q].y * v[q].y) + (v[q].z * v[q].z + v[q].w * v[q].w); }
        const float rstd = __builtin_amdgcn_rsqf(wave_sum(ss, lane) * (1.f / DM) + EPS);
#pragma unroll
        for (int q = 0; q < 4; ++q) { const int cc = 4 * lane + 256 * q; const f32x4 g = *(const f32x4*)(npost + cc), gt = *(const f32x4*)(mod + cc), xv = *(const f32x4*)(xr + cc);
            *(f32x4*)(dr + cc) = xv + gt * (v[q] * rstd * g); } }
}
__device__ __forceinline__ void postpre_rows(const float* slat, const float* sctx, float* dlat, float* dctx, const bf16_t* Y, const float* mods_post, const float* npost, int a0, int a1, bool write_ctx,
                                             const float* plat, const float* pctx, const float* mods_pre, const float* npre, bf16_t* H, int b0, int b1, int gw, int NGW, int lane) {
    const int lo = a0 < b0 ? a0 : b0, hi = a1 > b1 ? a1 : b1;
    for (int r = lo + gw; r < hi; r += 4 * NGW) {
        f32x4 x[4][4], v[4][4]; size_t off[4]; int cond[4]; bool inpost[4], inpre[4], isc[4], val[4]; int rr[4];
#pragma unroll
        for (int u = 0; u < 4; ++u) { const int rq = r + u * NGW; val[u] = rq < hi; rr[u] = val[u] ? rq : r; int b, i; row_info(rr[u], b, i);
            inpost[u] = rr[u] >= a0 && rr[u] < a1; inpre[u] = rr[u] >= b0 && rr[u] < b1; isc[u] = i < CTXL; cond[u] = isc[u] ? 8 : b;
            off[u] = isc[u] ? (size_t)(b * CTXL + i) * DM : (size_t)(b * LAT + i - CTXL) * DM;
            const float* xr = inpost[u] ? ((isc[u] ? sctx : slat) + off[u]) : ((isc[u] ? pctx : plat) + off[u]);
            const bf16_t* yr = Y + (inpost[u] ? (size_t)(rr[u] - a0) * DM : (size_t)0);
#pragma unroll
            for (int q = 0; q < 4; ++q) { x[u][q] = *(const f32x4*)(xr + 4 * lane + 256 * q); const u32x2 yw = *(const u32x2*)(yr + 4 * lane + 256 * q); v[u][q] = (f32x4){bflo(yw.x), bfhi(yw.x), bflo(yw.y), bfhi(yw.y)}; } }
#pragma unroll
        for (int u = 0; u < 4; ++u) {
            if (!val[u] || (!inpost[u] && !inpre[u])) continue;
            if (inpost[u]) {
                const float* mod = mods_post + (size_t)cond[u] * 3072 + 2048; float ss = 0.f;
#pragma unroll
                for (int q = 0; q < 4; ++q) ss += (v[u][q].x * v[u][q].x + v[u][q].y * v[u][q].y) + (v[u][q].z * v[u][q].z + v[u][q].w * v[u][q].w);
                const float rstd = __builtin_amdgcn_rsqf(wave_sum(ss, lane) * (1.f / DM) + EPS);
                float* dr = (isc[u] ? dctx : dlat) + off[u]; const bool wr = !isc[u] || write_ctx;
#pragma unroll
                for (int q = 0; q < 4; ++q) { const int cc = 4 * lane + 256 * q; const f32x4 g = *(const f32x4*)(npost + cc), gt = *(const f32x4*)(mod + cc);
                    x[u][q] = x[u][q] + gt * (v[u][q] * rstd * g); if (wr) *(f32x4*)(dr + cc) = x[u][q]; }
            }
            if (inpre[u]) {
                const float* mod = mods_pre + (size_t)cond[u] * 3072; float ss = 0.f;
#pragma unroll
                for (int q = 0; q < 4; ++q) ss += (x[u][q].x * x[u][q].x + x[u][q].y * x[u][q].y) + (x[u][q].z * x[u][q].z + x[u][q].w * x[u][q].w);
                const float rstd = __builtin_amdgcn_rsqf(wave_sum(ss, lane) * (1.f / DM) + EPS);
                bf16_t* hr = H + (size_t)(rr[u] - b0) * DM;
#pragma unroll
                for (int q = 0; q < 4; ++q) { const int cc = 4 * lane + 256 * q; const f32x4 g = *(const f32x4*)(npre + cc), sh = *(const f32x4*)(mod + cc), sc = *(const f32x4*)(mod + 1024 + cc);
                    const f32x4 h = x[u][q] * rstd * g * (sc + 1.f) + sh; u32x2 w; w.x = cvt_pk_bf16(h.x, h.y); w.y = cvt_pk_bf16(h.z, h.w); *(u32x2*)(hr + cc) = w; }
            }
        }
    }
}
__device__ __forceinline__ void hg_gate_rows(const bf16_t* OF, const bf16_t* OB, const bf16_t* Z, const float* ogain, bf16_t* G, int gw, int NGW, int lane) {
    const int gc = (lane & 15) * 8;
    const f32x4 g0 = *(const f32x4*)(ogain + gc), g1 = *(const f32x4*)(ogain + gc + 4);
    const float gg[8] = {g0.x, g0.y, g0.z, g0.w, g1.x, g1.y, g1.z, g1.w};
    for (int r = gw; r < TH; r += 2 * NGW) {
        u32x4 a[2][4], b[2][4], z[2][4]; bool val[2]; size_t ro[2];
#pragma unroll
        for (int u = 0; u < 2; ++u) { const int rq = r + u * NGW; val[u] = rq < TH; ro[u] = (size_t)(val[u] ? rq : r) * DI;
#pragma unroll
            for (int it = 0; it < 4; ++it) { const size_t off = ro[u] + (it * 64 + lane) * 8; a[u][it] = __builtin_nontemporal_load((const u32x4*)(OF + off)); b[u][it] = __builtin_nontemporal_load((const u32x4*)(OB + off)); z[u][it] = __builtin_nontemporal_load((const u32x4*)(Z + off)); } }
#pragma unroll
        for (int u = 0; u < 2; ++u) { if (!val[u]) continue;
#pragma unroll
            for (int it = 0; it < 4; ++it) { const size_t off = ro[u] + (it * 64 + lane) * 8; const u32x4 aa = a[u][it], bb = b[u][it], zz4 = z[u][it];
                float o[8]; o[0] = bflo(aa.x) + bflo(bb.x); o[1] = bfhi(aa.x) + bfhi(bb.x); o[2] = bflo(aa.y) + bflo(bb.y); o[3] = bfhi(aa.y) + bfhi(bb.y);
                o[4] = bflo(aa.z) + bflo(bb.z); o[5] = bfhi(aa.z) + bfhi(bb.z); o[6] = bflo(aa.w) + bflo(bb.w); o[7] = bfhi(aa.w) + bfhi(bb.w);
                float ss = 0.f;
#pragma unroll
                for (int e = 0; e < 8; ++e) ss += o[e] * o[e];
                ss += shx(ss, 1, lane); ss += shx(ss, 2, lane); ss += shx(ss, 4, lane); ss += shx(ss, 8, lane);
                const float rstd = __builtin_amdgcn_rsqf(ss * (1.f / 128.f) + EPS);
                const float zz[8] = {bflo(zz4.x), bfhi(zz4.x), bflo(zz4.y), bfhi(zz4.y), bflo(zz4.z), bfhi(zz4.z), bflo(zz4.w), bfhi(zz4.w)};
                float y[8];
#pragma unroll
                for (int e = 0; e < 8; ++e) y[e] = o[e] * rstd * gg[e] * silu_f(zz[e]);
                u32x4 w; w.x = cvt_pk_bf16(y[0], y[1]); w.y = cvt_pk_bf16(y[2], y[3]); w.z = cvt_pk_bf16(y[4], y[5]); w.w = cvt_pk_bf16(y[6], y[7]);
                *(u32x4*)(G + off) = w; } }
    }
}
__device__ __forceinline__ void mla_norm_rows(const bf16_t* SM, const float* qag, const float* kvg, const float* tab, bf16_t* QN, bf16_t* KC, int gw, int NGW, int lane) {
    for (int r4 = gw; r4 < T; r4 += 4 * NGW) { u32x4 a4[4];
#pragma unroll
      for (int u = 0; u < 4; ++u) { const int rq = r4 + u * NGW; a4[u] = *(const u32x4*)(SM + (size_t)(rq < T ? rq : r4) * 512 + lane * 8); }
#pragma unroll
      for (int u = 0; u < 4; ++u) { const int r = r4 + u * NGW; if (r >= T) continue; int b, i; row_info(r, b, i);
        const u32x4 a = a4[u];
        float v[8] = {bflo(a.x), bfhi(a.x), bflo(a.y), bfhi(a.y), bflo(a.z), bfhi(a.z), bflo(a.w), bfhi(a.w)};
        float ss = 0.f;
#pragma unroll
        for (int e = 0; e < 8; ++e) ss += v[e] * v[e];
        const float sq = wave_sum(lane < 32 ? ss : 0.f, lane), skv = wave_sum((lane >= 32 && lane < 48) ? ss : 0.f, lane);
        float px[8];
#pragma unroll
        for (int e = 0; e < 8; ++e) px[e] = shx(v[e], 4, lane);
        if (lane < 32) { const float rstd = __builtin_amdgcn_rsqf(sq * (1.f / 256.f) + EPS); const f32x4 g0 = *(const f32x4*)(qag + lane * 8), g1 = *(const f32x4*)(qag + lane * 8 + 4);
            u32x4 w; w.x = cvt_pk_bf16(v[0] * rstd * g0.x, v[1] * rstd * g0.y); w.y = cvt_pk_bf16(v[2] * rstd * g0.z, v[3] * rstd * g0.w);
            w.z = cvt_pk_bf16(v[4] * rstd * g1.x, v[5] * rstd * g1.y); w.w = cvt_pk_bf16(v[6] * rstd * g1.z, v[7] * rstd * g1.w);
            *(u32x4*)(QN + (size_t)r * 256 + lane * 8) = w; }
        else if (lane < 48) { const int c0 = (lane - 32) * 8; const float rstd = __builtin_amdgcn_rsqf(skv * (1.f / 128.f) + EPS); const f32x4 g0 = *(const f32x4*)(kvg + c0), g1 = *(const f32x4*)(kvg + c0 + 4);
            u32x4 w; w.x = cvt_pk_bf16(v[0] * rstd * g0.x, v[1] * rstd * g0.y); w.y = cvt_pk_bf16(v[2] * rstd * g0.z, v[3] * rstd * g0.w);
            w.z = cvt_pk_bf16(v[4] * rstd * g1.x, v[5] * rstd * g1.y); w.w = cvt_pk_bf16(v[6] * rstd * g1.z, v[7] * rstd * g1.w);
            *(u32x4*)(KC + (size_t)r * 192 + c0) = w; }
        else if (lane < 52) { const int j0 = (lane - 48) * 8;
            float o[16];
#pragma unroll
            for (int e = 0; e < 8; ++e) { const int j = j0 + e; float cs = 1.f, sn = 0.f;
                if (i >= CTXL) { const int t = i - CTXL; const int pos = j < 16 ? (t >> 6) : (t & 63); const int m = j & 15; cs = tab[(pos * 16 + m) * 2]; sn = tab[(pos * 16 + m) * 2 + 1]; }
                o[2 * e] = v[e] * cs - px[e] * sn; o[2 * e + 1] = v[e] * sn + px[e] * cs; }
            u32x4 w0, w1; w0.x = cvt_pk_bf16(o[0], o[1]); w0.y = cvt_pk_bf16(o[2], o[3]); w0.z = cvt_pk_bf16(o[4], o[5]); w0.w = cvt_pk_bf16(o[6], o[7]);
            w1.x = cvt_pk_bf16(o[8], o[9]); w1.y = cvt_pk_bf16(o[10], o[11]); w1.z = cvt_pk_bf16(o[12], o[13]); w1.w = cvt_pk_bf16(o[14], o[15]);
            bf16_t* kp = KC + (size_t)r * 192 + 128 + 2 * j0; *(u32x4*)kp = w0; *(u32x4*)(kp + 8) = w1; }
    } }
}

namespace scan {
constexpr int PQ = 136, PS = 40;
constexpr int O_QI = 0, O_QA = 8704, O_KA = 17408, O_KST = 26112, O_VT = 36352, O_P = 41472, O_ST0 = 44032, O_ST1 = 61440, O_BQ = 78848  , O_DEC = 82944;
__device__ __forceinline__ int tok(int p, int j, int dir) { if (dir == 0) return 32 * p + j; const int cc = p < 8 ? 7 - p : 143 - p; return 32 * cc + 31 - j; }
__device__ __forceinline__ void scan_phase(LAS unsigned char* lds, const bf16_t* QH, const bf16_t* VH, const _Float16* GFB  , bf16_t* OFB  , const float* lbl  , int jl, int& tidv) {
    const int tid = opaque_tid(tidv), w = __builtin_amdgcn_readfirstlane(tid >> 6), lane = tid & 63, fr = lane & 15, fq = lane >> 4;
    const int kp = tid & 63, tg = tid >> 6;
    const int vs = tid >> 4, vd = (tid & 15) * 4;
    LAS bf16_t* QI = (LAS bf16_t*)(lds + O_QI); LAS bf16_t* QA = (LAS bf16_t*)(lds + O_QA); LAS bf16_t* KA = (LAS bf16_t*)(lds + O_KA);
    LAS bf16_t* KST = (LAS bf16_t*)(lds + O_KST); LAS bf16_t* VT = (LAS bf16_t*)(lds + O_VT); LAS bf16_t* Pm = (LAS bf16_t*)(lds + O_P);
    LAS float* BQ = (LAS float*)(lds + O_BQ); LAS float* DEC = (LAS float*)(lds + O_DEC);
    constexpr float L2E = 1.4426950408889634f;
    for (int item = opaque_bid(); item < 256; item += gridDim.x) {
        const int dvh = item & 1, dir = (item >> 1) & 1, h = (item >> 2) & 15, bl = item >> 6;
        float lb0 = 0.f, lb1 = 0.f;
        if (jl == 1) { const f32x2 l0 = *(const f32x2*)(lbl + dir * DI + h * 128 + 2 * kp), l1 = *(const f32x2*)(lbl + 2 * DI + dir * DI + h * 128 + 2 * kp);
            lb0 = 1.f / (1.f + __expf(l0.x - l1.x)); lb1 = 1.f / (1.f + __expf(l0.y - l1.y)); }
        const float om0 = 1.f - lb0, om1 = 1.f - lb1;
        const size_t rowbase = (size_t)bl * TPB;
        const _Float16* Gp = GFB + (size_t)dir * ((size_t)TH * DI) + h * 128 + 2 * kp;
        const bf16_t* Qp = QH + h * 128 + 2 * kp;
        const bf16_t* Vp = VH + h * 128 + dvh * 64 + vd;
        bf16_t* Op = OFB + (size_t)dir * ((size_t)TH * DI) + h * 128 + dvh * 64;
        f32x4 S[4];
#pragma unroll
        for (int tv = 0; tv < 4; ++tv) S[tv] = (f32x4){0.f, 0.f, 0.f, 0.f};
        for (int i = tid; i < 17408 / 4; i += 512) ((LAS unsigned*)(lds + O_ST0))[i] = 0u;
        unsigned ggA[4], gqA[4], ggB[4], gqB[4]; u32x2 vrawA, vrawB;
#define SC_LOAD(pp, gg, gq, vraw) do { _Pragma("unroll") for (int j = 0; j < 4; ++j) { const size_t ro = (rowbase + tok((pp), 4 * tg + j, dir)) * DI; gg[j] = *(const unsigned*)(Gp + ro); gq[j] = *(const unsigned*)(Qp + ro); } \
        vraw = *(const u32x2*)(Vp + (rowbase + tok((pp), vs, dir)) * DI); } while (0)
        SC_LOAD(0, ggA, gqA, vrawA); SC_LOAD(1, ggB, gqB, vrawB);
        __syncthreads();
#define SC_STEP(p, gg, gq, vraw) do { \
            LAS bf16_t* STc = (LAS bf16_t*)(lds + ((p & 1) ? O_ST1 : O_ST0)); LAS bf16_t* STn = (LAS bf16_t*)(lds + ((p & 1) ? O_ST0 : O_ST1)); \
            float kk0[4], kk1[4], cu0[4], cu1[4]; float c0 = 0.f, c1 = 0.f; \
_Pragma("unroll") \
            for (int j = 0; j < 4; ++j) { const h16x2 gh = __builtin_bit_cast(h16x2, gg[j]); \
                const float g0 = fminf(fmaxf((float)gh.x, -30.f), 30.f), g1 = fminf(fmaxf((float)gh.y, -30.f), 30.f); \
                const float s0 = __builtin_amdgcn_rcpf(1.f + __builtin_amdgcn_exp2f(-L2E * g0)), s1 = __builtin_amdgcn_rcpf(1.f + __builtin_amdgcn_exp2f(-L2E * g1)); \
                c0 += __builtin_amdgcn_logf(lb0 + om0 * s0); c1 += __builtin_amdgcn_logf(lb1 + om1 * s1); cu0[j] = c0; cu1[j] = c1; \
                kk0[j] = om0 - om0 * s0; kk1[j] = om1 - om1 * s1; } \
            *(LAS f32x2*)(BQ + tg * 128 + 2 * kp) = (f32x2){c0, c1}; \
            __syncthreads(); \
            { float pre0 = 0.f, pre1 = 0.f, mid0 = 0.f, mid1 = 0.f, tot0 = 0.f, tot1 = 0.f; \
_Pragma("unroll") \
              for (int g = 0; g < 8; ++g) { const f32x2 v = *(const LAS f32x2*)(BQ + g * 128 + 2 * kp); \
                  if (g < tg) { pre0 += v.x; pre1 += v.y; } if (g < 4) { mid0 += v.x; mid1 += v.y; } tot0 += v.x; tot1 += v.y; } \
              const float em0 = __builtin_amdgcn_exp2f(mid0), em1 = __builtin_amdgcn_exp2f(mid1), el0 = __builtin_amdgcn_exp2f(tot0 - mid0), el1 = __builtin_amdgcn_exp2f(tot1 - mid1); \
              unsigned ks0[2], ks1[2]; \
_Pragma("unroll") \
              for (int j = 0; j < 4; ++j) { const int t = 4 * tg + j; \
                  const float x0 = fminf(fmaxf(pre0 + cu0[j] - mid0, -115.f), 115.f), x1 = fminf(fmaxf(pre1 + cu1[j] - mid1, -115.f), 115.f); \
                  const float a0 = __builtin_amdgcn_exp2f(x0), a1 = __builtin_amdgcn_exp2f(x1), r0 = __builtin_amdgcn_rcpf(a0), r1 = __builtin_amdgcn_rcpf(a1); \
                  const float qa0 = bflo(gq[j]) * a0, qa1 = bfhi(gq[j]) * a1, ka0 = kk0[j] * r0, ka1 = kk1[j] * r1; \
                  *(LAS unsigned*)(QA + t * PQ + 2 * kp) = cvt_pk_bf16(qa0, qa1); \
                  *(LAS unsigned*)(QI + t * PQ + 2 * kp) = cvt_pk_bf16(qa0 * em0, qa1 * em1); \
                  *(LAS unsigned*)(KA + t * PQ + 2 * kp) = cvt_pk_bf16(ka0, ka1); \
                  const unsigned kz = cvt_pk_bf16(ka0 * el0, ka1 * el1);       \
                  if (j & 1) { ks0[j >> 1] |= kz << 16; ks1[j >> 1] |= kz & 0xffff0000u; } else { ks0[j >> 1] = kz & 0xffffu; ks1[j >> 1] = kz >> 16; } } \
              *(LAS u32x2*)(KST + (2 * kp) * PS + 4 * tg) = (u32x2){ks0[0], ks0[1]}; \
              *(LAS u32x2*)(KST + (2 * kp + 1) * PS + 4 * tg) = (u32x2){ks1[0], ks1[1]}; \
              if (tg == 0) *(LAS f32x2*)(DEC + 2 * kp) = (f32x2){__builtin_amdgcn_exp2f(tot0), __builtin_amdgcn_exp2f(tot1)}; \
              VT[(vd + 0) * PS + vs] = (bf16_t)(vraw.x & 0xffffu); VT[(vd + 1) * PS + vs] = (bf16_t)(vraw.x >> 16); \
              VT[(vd + 2) * PS + vs] = (bf16_t)(vraw.y & 0xffffu); VT[(vd + 3) * PS + vs] = (bf16_t)(vraw.y >> 16); } \
            __syncthreads(); \
            if (p + 2 < 136) SC_LOAD(p + 2, gg, gq, vraw); \
            if (w < 4) {    \
                const int tm = w >> 1, tn = w & 1; f32x4 sc = (f32x4){0.f, 0.f, 0.f, 0.f}; \
_Pragma("unroll") \
                for (int ks = 0; ks < 4; ++ks) { const bf16x8 X = *(const LAS bf16x8*)(QA + (16 * tm + fr) * PQ + 32 * ks + 8 * fq), Y = *(const LAS bf16x8*)(KA + (16 * tn + fr) * PQ + 32 * ks + 8 * fq); \
                    sc = __builtin_amdgcn_mfma_f32_16x16x32_bf16(X, Y, sc, 0, 0, 0); } \
                const int s = 16 * tn + fr; \
_Pragma("unroll") \
                for (int e = 0; e < 4; ++e) { const int t = 16 * tm + 4 * fq + e; Pm[t * PS + s] = (bf16_t)((s <= t) ? f2bf(sc[e]) : 0u); } \
            } \
            const int tm = w >> 2, tn = w & 3; f32x4 oa = (f32x4){0.f, 0.f, 0.f, 0.f}; \
_Pragma("unroll") \
            for (int ks = 0; ks < 4; ++ks) { const bf16x8 X = *(const LAS bf16x8*)(QI + (16 * tm + fr) * PQ + 32 * ks + 8 * fq), Y = *(const LAS bf16x8*)(STc + (16 * tn + fr) * PQ + 32 * ks + 8 * fq); \
                oa = __builtin_amdgcn_mfma_f32_16x16x32_bf16(X, Y, oa, 0, 0, 0); } \
            { const bf16x8 X = *(const LAS bf16x8*)(KST + (16 * w + fr) * PS + 8 * fq); const f32x4 dec = *(const LAS f32x4*)(DEC + 16 * w + 4 * fq); \
_Pragma("unroll") \
              for (int tv = 0; tv < 4; ++tv) { const bf16x8 Y = *(const LAS bf16x8*)(VT + (16 * tv + fr) * PS + 8 * fq); \
                  S[tv] = __builtin_amdgcn_mfma_f32_16x16x32_bf16(X, Y, S[tv] * dec, 0, 0, 0); \
                  u32x2 sw; sw.x = cvt_pk_bf16(S[tv][0], S[tv][1]); sw.y = cvt_pk_bf16(S[tv][2], S[tv][3]); \
                  *(LAS u32x2*)(STn + (16 * tv + fr) * PQ + 16 * w + 4 * fq) = sw; } } \
            __syncthreads(); \
            { const bf16x8 X = *(const LAS bf16x8*)(Pm + (16 * tm + fr) * PS + 8 * fq), Y = *(const LAS bf16x8*)(VT + (16 * tn + fr) * PS + 8 * fq); \
              oa = __builtin_amdgcn_mfma_f32_16x16x32_bf16(X, Y, oa, 0, 0, 0); } \
_Pragma("unroll") \
            for (int e = 0; e < 4; ++e) { const int t = 16 * tm + 4 * fq + e; Op[(rowbase + tok(p, t, dir)) * DI + 16 * tn + fr] = (bf16_t)f2bf(oa[e]); } \
        } while (0)
        for (int p2 = 0; p2 < 136; p2 += 2) { SC_STEP(p2, ggA, gqA, vrawA); SC_STEP(p2 + 1, ggB, gqB, vrawB); }
        __syncthreads();
#undef SC_LOAD
#undef SC_STEP
    }
}
}


typedef const __attribute__((address_space(4))) Params* KParams;
__device__ __forceinline__ KParams kp_get() { KParams q = (KParams)__builtin_amdgcn_kernarg_segment_ptr(); asm volatile("" : "+s"(q)); return q; }
namespace scan2 {
constexpr int PQ = 136, PS = 40;
constexpr int BUF = 41984, B_QI = 0, B_QA = 8704, B_KA = 17408, B_KST = 26112, B_VT = 36352, B_DEC = 41472;
constexpr int O_P = 2 * BUF, O_ST0 = O_P + 2560, O_ST1 = O_ST0 + 17408, O_BQ = O_ST1 + 17408;
__device__ __forceinline__ int tok(int p, int j, int dir) { if (dir == 0) return 32 * p + j; const int cc = p < 8 ? 7 - p : 143 - p; return 32 * cc + 31 - j; }
#define QI ((LAS bf16_t*)(bufp + B_QI))
#define QA ((LAS bf16_t*)(bufp + B_QA))
#define KA ((LAS bf16_t*)(bufp + B_KA))
#define KST ((LAS bf16_t*)(bufp + B_KST))
#define VT ((LAS bf16_t*)(bufp + B_VT))
#define DEC ((LAS float*)(bufp + B_DEC))
#ifndef PROBE_ID
#define PROBE_ID 0
#endif
#define SCT0(id, cond) do { if (PROBE_ID == (id) && blockIdx.x == 0 && (cond) && lane == 0) sct_ = __builtin_amdgcn_s_memrealtime(); } while (0)
#define SCT1(id, cond) do { if (PROBE_ID == (id) && blockIdx.x == 0 && (cond) && lane == 0) { volatile LAS unsigned long long* q_ = (volatile LAS unsigned long long*)(lds + 147456 - 32); q_[1] = q_[1] + (__builtin_amdgcn_s_memrealtime() - sct_); } } while (0)
#define SC2_BAR() do { asm volatile("s_waitcnt lgkmcnt(0)" ::: "memory"); __builtin_amdgcn_s_barrier(); asm volatile("" ::: "memory"); } while (0)
__device__ __forceinline__ void scan_phase(LAS unsigned char* lds, int jl, int& tidv) {
    const int tid = opaque_tid(tidv), w = __builtin_amdgcn_readfirstlane(tid >> 6), lane = tid & 63, fr = lane & 15, fq = lane >> 4;
    constexpr float L2E = 1.4426950408889634f; unsigned long long sct_ = 0ull; (void)sct_;
    LAS bf16_t* Pm = (LAS bf16_t*)(lds + O_P); LAS float* BQ = (LAS float*)(lds + O_BQ);
    { const int bid_ = opaque_bid() & 255;
      const int item = ((((bid_ >> 3) >> 2) * 8 + (bid_ & 7)) << 2) | ((bid_ >> 3) & 3);
        const int dvh = item & 1, dir = (item >> 1) & 1, h = (item >> 2) & 15, bl = item >> 6;
        const KParams kq_ = kp_get(); unsigned char* ws_ = kq_->ws; const bf16_t* QH = (const bf16_t*)(ws_ + WS_HG_P); const bf16_t* VH = QH + (size_t)TH * DI; const _Float16* GFB = (const _Float16*)(QH + 2 * (size_t)TH * DI);
        bf16_t* OFB = (bf16_t*)(ws_ + WS_HG_OF); const float* lbl = kq_->hg_lb;
        const unsigned rowbase = (unsigned)bl * TPB;
        for (int i = tid; i < 17408 / 4; i += 512) ((LAS unsigned*)(lds + O_ST0))[i] = 0u;
        SC2_BAR();
        if (w < 4) {
            const int kp = tid & 63, tg = w;
            float lb0 = 0.f, lb1 = 0.f;
            if (jl == 1) { const f32x2 l0 = *(const f32x2*)(lbl + dir * DI + h * 128 + 2 * kp), l1 = *(const f32x2*)(lbl + 2 * DI + dir * DI + h * 128 + 2 * kp);
                lb0 = 1.f / (1.f + __expf(l0.x - l1.x)); lb1 = 1.f / (1.f + __expf(l0.y - l1.y)); }
            const float om0 = 1.f - lb0, om1 = 1.f - lb1;
            const char* Gb = (const char*)(GFB + (size_t)dir * ((size_t)TH * DI) + h * 128); const char* Qb = (const char*)(QH + h * 128); const unsigned lo4 = (unsigned)kp * 4u;
            unsigned ggA[8], gqA[8], ggB[8], gqB[8];
#define SC2_LOAD_GV(pp, gg, vr) do { _Pragma("unroll") for (int j = 0; j < 8; ++j) { const unsigned rb = (rowbase + (unsigned)tok((pp), 8 * tg + j, dir)) * (DI * 2); gg[j] = *(const unsigned*)(Gb + rb + lo4); } } while (0)
#define SC2_LOAD_Q(pp, gq) do { _Pragma("unroll") for (int j = 0; j < 8; ++j) { const unsigned rb = (rowbase + (unsigned)tok((pp), 8 * tg + j, dir)) * (DI * 2); gq[j] = *(const unsigned*)(Qb + rb + lo4); } } while (0)
#define SC2_LOAD(pp, gg, gq, vr) do { SC2_LOAD_GV(pp, gg, vr); SC2_LOAD_Q(pp, gq); } while (0)
#define SC2_PREP(n, gg, gq, vr) do { \
            LAS unsigned char* bufp = lds + ((n) & 1) * BUF; \
            SCT0(21, w == 0); \
            float kk0[8], kk1[8], av0[8], av1[8], rv0[8], rv1[8], f0_[8], f1_[8], q0_[8], q1_[8]; \
            _Pragma("unroll") for (int j = 0; j < 8; ++j) { const h16x2 gh = __builtin_bit_cast(h16x2, gg[j]); \
                const float g0 = fmaxf((float)gh.x, -13.8f), g1 = fmaxf((float)gh.y, -13.8f); \
                const float u0 = 1.f + __builtin_amdgcn_exp2f(-L2E * g0), u1 = 1.f + __builtin_amdgcn_exp2f(-L2E * g1); \
                const float s0 = __builtin_amdgcn_rcpf(u0), s1 = __builtin_amdgcn_rcpf(u1); \
                f0_[j] = lb0 + om0 * s0; f1_[j] = lb1 + om1 * s1; q0_[j] = (jl == 0) ? u0 : __builtin_amdgcn_rcpf(f0_[j]); q1_[j] = (jl == 0) ? u1 : __builtin_amdgcn_rcpf(f1_[j]); \
                kk0[j] = 1.f - f0_[j]; kk1[j] = 1.f - f1_[j]; } \
            { float pf0 = 1.f, pf1 = 1.f, pr0 = 1.f, pr1 = 1.f; \
              if (tg >= 2) { _Pragma("unroll") for (int j = 0; j < 8; ++j) { pf0 *= f0_[j]; pf1 *= f1_[j]; pr0 *= q0_[j]; pr1 *= q1_[j]; av0[j] = pf0; av1[j] = pf1; rv0[j] = pr0; rv1[j] = pr1; } } \
              else { _Pragma("unroll") for (int j = 7; j >= 0; --j) { av0[j] = pr0; av1[j] = pr1; rv0[j] = pf0; rv1[j] = pf1; pf0 *= f0_[j]; pf1 *= f1_[j]; pr0 *= q0_[j]; pr1 *= q1_[j]; } } \
              *(LAS f32x4*)(BQ + (tg * 64 + kp) * 4) = (f32x4){pf0, pf1, pr0, pr1}; } \
            float qf0[8], qf1[8]; _Pragma("unroll") for (int j = 0; j < 8; ++j) { qf0[j] = bflo(gq[j]); qf1[j] = bfhi(gq[j]); } \
            if ((n) + 2 < 136) { SC2_LOAD_GV((n) + 2, gg, vr); SC2_LOAD_Q((n) + 2, gq); } \
            if (PROBE_ID == 21) asm volatile("s_waitcnt lgkmcnt(0)" ::: "memory"); SCT1(21, w == 0); \
            SC2_BAR(); SCT0(22, w == 0); \
            { const f32x4 b0 = *(const LAS f32x4*)(BQ + (0 * 64 + kp) * 4), b1 = *(const LAS f32x4*)(BQ + (1 * 64 + kp) * 4), b2 = *(const LAS f32x4*)(BQ + (2 * 64 + kp) * 4), b3 = *(const LAS f32x4*)(BQ + (3 * 64 + kp) * 4); \
              const float em0 = b0[0] * b1[0], em1 = b0[1] * b1[1], el0 = b2[0] * b3[0], el1 = b2[1] * b3[1]; \
              float ca0 = 1.f, ca1 = 1.f, cr0 = 1.f, cr1 = 1.f; \
              if (tg == 0) { ca0 = b1[2]; ca1 = b1[3]; cr0 = b1[0]; cr1 = b1[1]; } else if (tg == 3) { ca0 = b2[0]; ca1 = b2[1]; cr0 = b2[2]; cr1 = b2[3]; } \
              unsigned ks0[4], ks1[4]; \
              _Pragma("unroll") for (int j = 0; j < 8; ++j) { const int t = 8 * tg + j; \
                  const float a0 = __builtin_amdgcn_fmed3f(av0[j] * ca0, 1e-30f, 1e30f), a1 = __builtin_amdgcn_fmed3f(av1[j] * ca1, 1e-30f, 1e30f); \
                  const float r0 = __builtin_amdgcn_fmed3f(rv0[j] * cr0, 1e-30f, 1e30f), r1 = __builtin_amdgcn_fmed3f(rv1[j] * cr1, 1e-30f, 1e30f); \
                  const float qa0 = qf0[j] * a0, qa1 = qf1[j] * a1, ka0 = kk0[j] * r0, ka1 = kk1[j] * r1; \
                  *(LAS unsigned*)(QA + t * PQ + 2 * kp) = cvt_pk_bf16(qa0, qa1); \
                  *(LAS unsigned*)(QI + t * PQ + 2 * kp) = cvt_pk_bf16(qa0 * em0, qa1 * em1); \
                  *(LAS unsigned*)(KA + t * PQ + 2 * kp) = cvt_pk_bf16(ka0, ka1); \
                  const unsigned kz = cvt_pk_bf16(ka0 * el0, ka1 * el1); \
                  if (j & 1) { ks0[j >> 1] |= kz << 16; ks1[j >> 1] |= kz & 0xffff0000u; } else { ks0[j >> 1] = kz & 0xffffu; ks1[j >> 1] = kz >> 16; } } \
              *(LAS u32x4*)(KST + (2 * kp) * PS + 8 * tg) = (u32x4){ks0[0], ks0[1], ks0[2], ks0[3]}; \
              *(LAS u32x4*)(KST + (2 * kp + 1) * PS + 8 * tg) = (u32x4){ks1[0], ks1[1], ks1[2], ks1[3]}; \
              if (tg == 0) *(LAS f32x2*)(DEC + 2 * kp) = (f32x2){em0 * el0, em1 * el1}; \
              } \
            if (PROBE_ID == 22) asm volatile("s_waitcnt lgkmcnt(0)" ::: "memory"); SCT1(22, w == 0); \
            SC2_BAR(); \
        } while (0)
            SC2_LOAD(0, ggA, gqA, 0); SC2_LOAD(1, ggB, gqB, 0);
            for (int n2 = 0; n2 < 136; n2 += 2) { SC2_PREP(n2, ggA, gqA, 0); SC2_PREP(n2 + 1, ggB, gqB, 0); }
            SC2_BAR(); SC2_BAR();
#undef SC2_LOAD
#undef SC2_LOAD_GV
#undef SC2_LOAD_Q
#undef SC2_PREP
        } else {
            const int wm = w - 4;
            const int vs = tid & 31, vd = ((tid >> 5) & 7) * 8;
            const bf16_t* Vp = VH + h * 128 + dvh * 64 + vd;
            u32x4 vr = *(const u32x4*)(Vp + (rowbase + (unsigned)tok(0, vs, dir)) * DI);
#define SC2_VT(nn) do { LAS bf16_t* vt_ = (LAS bf16_t*)(lds + ((nn) & 1) * BUF + B_VT); \
            vt_[(vd + 0) * PS + vs] = (bf16_t)(vr.x & 0xffffu); vt_[(vd + 1) * PS + vs] = (bf16_t)(vr.x >> 16); vt_[(vd + 2) * PS + vs] = (bf16_t)(vr.y & 0xffffu); vt_[(vd + 3) * PS + vs] = (bf16_t)(vr.y >> 16); \
            vt_[(vd + 4) * PS + vs] = (bf16_t)(vr.z & 0xffffu); vt_[(vd + 5) * PS + vs] = (bf16_t)(vr.z >> 16); vt_[(vd + 6) * PS + vs] = (bf16_t)(vr.w & 0xffffu); vt_[(vd + 7) * PS + vs] = (bf16_t)(vr.w >> 16); \
            if ((nn) + 1 < 136) vr = *(const u32x4*)(Vp + (rowbase + (unsigned)tok((nn) + 1, vs, dir)) * DI); } while (0)
            bf16_t* Op = OFB + (size_t)dir * ((size_t)TH * DI) + h * 128 + dvh * 64;
            f32x4 S[2][4];
#pragma unroll
            for (int kt = 0; kt < 2; ++kt)
#pragma unroll
                for (int tv = 0; tv < 4; ++tv) S[kt][tv] = (f32x4){0.f, 0.f, 0.f, 0.f};
            SC2_VT(0);
            SC2_BAR(); SC2_BAR();
            for (int n = 1; n <= 136; ++n) {
                const int p = n - 1;
                LAS unsigned char* bufp = lds + (p & 1) * BUF;
                LAS bf16_t* STc = (LAS bf16_t*)(lds + ((p & 1) ? O_ST1 : O_ST0)); LAS bf16_t* STn = (LAS bf16_t*)(lds + ((p & 1) ? O_ST0 : O_ST1));
                SCT0(23, w == 4);
                {
                    const int tm = wm >> 1, tn = wm & 1; f32x4 sc = (f32x4){0.f, 0.f, 0.f, 0.f};
#pragma unroll
                    for (int ks = 0; ks < 4; ++ks) { const bf16x8 X = *(const LAS bf16x8*)(QA + (16 * tm + fr) * PQ + 32 * ks + 8 * fq), Y = *(const LAS bf16x8*)(KA + (16 * tn + fr) * PQ + 32 * ks + 8 * fq);
                        sc = __builtin_amdgcn_mfma_f32_16x16x32_bf16(X, Y, sc, 0, 0, 0); }
                    const int s_ = 16 * tn + fr;
#pragma unroll
                    for (int e = 0; e < 4; ++e) { const int t = 16 * tm + 4 * fq + e; Pm[t * PS + s_] = (bf16_t)((s_ <= t) ? (cvt_pk_bf16(sc[e], 0.f) & 0xffffu) : 0u); }
                }
                {
                    bf16x8 Yv[4];
#pragma unroll
                    for (int tv = 0; tv < 4; ++tv) Yv[tv] = *(const LAS bf16x8*)(VT + (16 * tv + fr) * PS + 8 * fq);
#pragma unroll
                    for (int kt = 0; kt < 2; ++kt) { const int k0 = 32 * wm + 16 * kt; const bf16x8 X = *(const LAS bf16x8*)(KST + (k0 + fr) * PS + 8 * fq); const f32x4 dec = *(const LAS f32x4*)(DEC + k0 + 4 * fq);
#pragma unroll
                        for (int tv = 0; tv < 4; ++tv) { S[kt][tv] = __builtin_amdgcn_mfma_f32_16x16x32_bf16(X, Yv[tv], S[kt][tv] * dec, 0, 0, 0);
                            u32x2 sw; sw.x = cvt_pk_bf16(S[kt][tv][0], S[kt][tv][1]); sw.y = cvt_pk_bf16(S[kt][tv][2], S[kt][tv][3]);
                            *(LAS u32x2*)(STn + (16 * tv + fr) * PQ + k0 + 4 * fq) = sw; } }
                }
                if (PROBE_ID == 23) asm volatile("s_waitcnt lgkmcnt(0)" ::: "memory"); SCT1(23, w == 4);
                SC2_BAR(); SCT0(24, w == 4);
                f32x4 oa[2];
                {
                    oa[0] = (f32x4){0.f, 0.f, 0.f, 0.f}; oa[1] = oa[0];
#pragma unroll
                    for (int ks = 0; ks < 4; ++ks) { const bf16x8 Y = *(const LAS bf16x8*)(STc + (16 * wm + fr) * PQ + 32 * ks + 8 * fq);
                        const bf16x8 X0 = *(const LAS bf16x8*)(QI + fr * PQ + 32 * ks + 8 * fq), X1 = *(const LAS bf16x8*)(QI + (16 + fr) * PQ + 32 * ks + 8 * fq);
                        oa[0] = __builtin_amdgcn_mfma_f32_16x16x32_bf16(X0, Y, oa[0], 0, 0, 0); oa[1] = __builtin_amdgcn_mfma_f32_16x16x32_bf16(X1, Y, oa[1], 0, 0, 0); }
                }
                {
                    const bf16x8 Y = *(const LAS bf16x8*)(VT + (16 * wm + fr) * PS + 8 * fq);
                    const bf16x8 X0 = *(const LAS bf16x8*)(Pm + fr * PS + 8 * fq), X1 = *(const LAS bf16x8*)(Pm + (16 + fr) * PS + 8 * fq);
                    oa[0] = __builtin_amdgcn_mfma_f32_16x16x32_bf16(X0, Y, oa[0], 0, 0, 0); oa[1] = __builtin_amdgcn_mfma_f32_16x16x32_bf16(X1, Y, oa[1], 0, 0, 0);
#pragma unroll
                    for (int tm = 0; tm < 2; ++tm)
#pragma unroll
                        for (int e = 0; e < 4; ++e) { const int t = 16 * tm + 4 * fq + e; Op[(rowbase + (unsigned)tok(p, t, dir)) * DI + 16 * wm + fr] = (bf16_t)(cvt_pk_bf16(oa[tm][e], 0.f) & 0xffffu); }
                }
                if (n < 136) SC2_VT(n);
                SCT1(24, w == 4);
                SC2_BAR();
            }
        }
        SC2_BAR();
    }
}
#undef SC2_BAR
#undef SC2_VT
#undef SCT0
#undef SCT1
#undef QI
#undef QA
#undef KA
#undef KST
#undef VT
#undef DEC
}

#define XB_TMO      128
#define XB_XCNT(j)  (256  + 64 * (j))
#define XB_XSUB(j)  (1280 + 64 * (j))
#define XB_XGEN(j)  (2304 + 64 * (j))
#define XB_TOP      3328
#define XB_TOPGEN   3392
#define XCD_BAR_WORDS 3456
#define XB_SPIN_CAP (1u << 18)
__device__ __forceinline__ unsigned xb_ld(unsigned* p)              { return __hip_atomic_load(p, __ATOMIC_RELAXED, __HIP_MEMORY_SCOPE_AGENT); }
__device__ __forceinline__ unsigned xb_add(unsigned* p, unsigned v) { return __hip_atomic_fetch_add(p, v, __ATOMIC_RELAXED, __HIP_MEMORY_SCOPE_AGENT); }
__device__ __forceinline__ unsigned xb_xcc_id() { return (unsigned)__builtin_amdgcn_s_getreg((3 << 11) | 20) & 0xFu; }
#define XB_SPIN(cond, bar) do { unsigned _sp = 0; while (cond) { __builtin_amdgcn_s_sleep(1); \
    if ((++_sp & 255u) == 0u) { if (xb_ld(&(bar)[XB_TMO])) break; if (_sp > XB_SPIN_CAP) { atomicAdd(&(bar)[XB_TMO], 1u); break; } } } } while (0)
__device__ __forceinline__ void xcd_barrier_complete(unsigned* bar, unsigned x, unsigned& nloc, unsigned& nx) {
    const unsigned G = gridDim.x * gridDim.y * gridDim.z;
    unsigned sum, cnt, mine, sp = 0u;
    for (;;) {
        sum = 0u; cnt = 0u; mine = 0u;
#pragma unroll
        for (unsigned j = 0; j < 16; ++j) { const unsigned c = xb_ld(&bar[XB_XCNT(j)]); sum += c; cnt += (c > 0u) ? 1u : 0u; mine = (j == x) ? c : mine; }
        if (sum == G) break;
        __builtin_amdgcn_s_sleep(1);
        if ((++sp & 255u) == 0u) { if (xb_ld(&bar[XB_TMO])) break; if (sp > XB_SPIN_CAP) { atomicAdd(&bar[XB_TMO], 1u); break; } }
    }
    nloc = mine > 0u ? mine : 1u; nx = cnt > 0u ? cnt : 1u;
}
__device__ __forceinline__ void xcd_barrier(unsigned* bar, volatile LAS unsigned* st, bool is_t0) {
    asm volatile("s_waitcnt vmcnt(0)" ::: "memory");
    __syncthreads();
    if (is_t0) {
        const unsigned x = xb_xcc_id();
        __builtin_amdgcn_s_waitcnt(0);
        unsigned nloc = st[0], nx = st[1];
        if (nloc == 0u) { xcd_barrier_complete(bar, x, nloc, nx); st[0] = nloc; st[1] = nx; }
        const unsigned old = xb_add(&bar[XB_XSUB(x)], 1u);
        const unsigned gen = old / nloc;
        if (old + 1u == (gen + 1u) * nloc) {
            __builtin_amdgcn_fence(__ATOMIC_RELEASE, "agent");
            asm volatile("s_waitcnt vmcnt(0)" ::: "memory");
            const unsigned og = xb_add(&bar[XB_TOP], 1u);
            const unsigned tg = og / nx;
            if (og + 1u == (tg + 1u) * nx) xb_add(&bar[XB_TOPGEN], 1u);
            else XB_SPIN(xb_ld(&bar[XB_TOPGEN]) == tg, bar);
            __builtin_amdgcn_fence(__ATOMIC_ACQUIRE, "agent");
            xb_add(&bar[XB_XGEN(x)], 1u);
            asm volatile("s_waitcnt vmcnt(0)" ::: "memory");
        } else {
            XB_SPIN(xb_ld(&bar[XB_XGEN(x)]) == gen, bar);
            __builtin_amdgcn_fence(__ATOMIC_ACQUIRE, "agent");
            asm volatile("s_waitcnt vmcnt(0)" ::: "memory");
        }
    }
    __syncthreads();
}

#ifndef GEMM_MASK
#define GEMM_MASK 63
#endif
#define GEMM_CALLN(n) do { if constexpr ((GEMM_MASK >> (n)) & 1) pg8::gemm_phase(lds, g, S, E, tidv); else { (void)g; (void)S; (void)E; } } while (0)
#define KP(field) (kp_get()->field)


#define IDS const int tid = opaque_tid(tidv), lane = tid & 63, wave = __builtin_amdgcn_readfirstlane(tid >> 6); (void)tid; (void)lane; (void)wave
#ifndef PROBE_ID
#define PROBE_ID 0
#endif
#define PROBE_MATCH(id) (PROBE_ID == 100 ? ((id) == 2 || (id) == 5 || (id) == 8 || (id) == 10 || (id) == 12 || (id) == 13) : (PROBE_ID == 101 ? ((id) == 4 || (id) == 6 || (id) == 9 || (id) == 14 || (id) == 15) : PROBE_ID == (id)))
#define PT_BEGIN(id) do { if (PROBE_MATCH(id) && blockIdx.x == 0 && tidv == 0) { *(volatile LAS unsigned long long*)(lds + 147456 - 32) = __builtin_amdgcn_s_memrealtime(); } } while (0)
#define PT_END(id) do { if (PROBE_MATCH(id) && blockIdx.x == 0 && tidv == 0) { volatile LAS unsigned long long* q_ = (volatile LAS unsigned long long*)(lds + 147456 - 32); q_[1] = q_[1] + (__builtin_amdgcn_s_memrealtime() - q_[0]); } } while (0)
#define LPV lp
#define CGSYNC() do { PT_BEGIN(16); asm volatile("s_waitcnt vmcnt(0) lgkmcnt(0)" ::: "memory"); grid.sync(); __builtin_amdgcn_fence(__ATOMIC_ACQUIRE, "agent"); asm volatile("s_waitcnt vmcnt(0)" ::: "memory"); PT_END(16); } while (0)
#define GSYNC() do { PT_BEGIN(16); xcd_barrier((unsigned*)(kp_get()->ws) + 1024, (volatile LAS unsigned*)(lds + 147456 - 64), tidv == 0); PT_END(16); } while (0)
#define GW (opaque_bid() * 8 + wave)
#define NGW_ ((int)gridDim.x * 8)
template <int lp, int hf>
__device__ __forceinline__ void hgrn_pass(LAS unsigned char* lds, unsigned char* lds_raw, cg::grid_group& grid, int& tidv) { PT_BEGIN(1);

                const int r0 = hf * TH, r1 = r0 + TH;
                PT_BEGIN(2);
                { unsigned char* ws = KP(ws);
                  pg8::Gemm g{(const bf16_t*)(ws + WS_HG_H), (const bf16_t*)(ws + WS_HG_WIN), TH, 10240, DM, DM, DM, 0}; pg8::StaticOrder S; S.init(TH, 10240, (int)gridDim.x, opaque_bid());
                  pg8::EpiHgIn E{(bf16_t*)(ws + WS_HG_P)}; GEMM_CALLN(0); }
                GSYNC(); PT_END(2); PT_BEGIN(3);
#ifndef NO_SCAN
                scan2::scan_phase(lds, LPV, tidv);
#endif
                GSYNC(); PT_END(3); PT_BEGIN(4);
                { IDS; KParams k = kp_get(); unsigned char* ws = k->ws; bf16_t* OFb = (bf16_t*)(ws + WS_HG_OF);
                  hg_gate_rows(OFb, OFb + (size_t)TH * DI, (const bf16_t*)(ws + WS_HG_P) + 4 * (size_t)TH * DI, k->hg_o_norm + LPV * 128, (bf16_t*)(ws + WS_HG_GATED), GW, NGW_, lane); }
                GSYNC(); PT_END(4); PT_BEGIN(5);
                { unsigned char* ws = KP(ws);
                  pg8::Gemm g{(const bf16_t*)(ws + WS_HG_GATED), (const bf16_t*)(ws + WS_HG_WOUT), TH, DM, DI, DI, DI, 0}; pg8::StaticOrder S; S.init(TH, DM, (int)gridDim.x, opaque_bid());
                  pg8::EpiF32 E{(bf16_t*)(ws + WS_HG_Y)}; GEMM_CALLN(1); }
                GSYNC(); PT_END(5); PT_BEGIN(6);
                { IDS; KParams k = kp_get(); unsigned char* ws = k->ws; float* xctx = (float*)(ws + WS_XCTX); const float* mods = (const float*)(ws + WS_MODS);
                  const float* slat = LPV == 0 ? k->x : k->out; const float* sctx = LPV == 0 ? k->ctx : (const float*)xctx;
                  if (hf == 0)
                      postpre_rows(slat, sctx, k->out, xctx, (const bf16_t*)(ws + WS_HG_Y), mods + (size_t)(2 * LPV) * 9 * 3072, k->norm_post + (2 * LPV) * DM, r0, r1, true,
                                   slat, sctx, mods + (size_t)(2 * LPV) * 9 * 3072, k->norm_pre + (2 * LPV) * DM, (bf16_t*)(ws + WS_HG_H), TH, T, GW, NGW_, lane);
                  else
                      postpre_rows(slat, sctx, k->out, xctx, (const bf16_t*)(ws + WS_HG_Y), mods + (size_t)(2 * LPV) * 9 * 3072, k->norm_post + (2 * LPV) * DM, r0, r1, true,
                                   k->out, xctx, mods + (size_t)(2 * LPV + 1) * 9 * 3072, k->norm_pre + (2 * LPV + 1) * DM, (bf16_t*)(ws + WS_ML_H), 0, T, GW, NGW_, lane); }
                if (hf == 1) { IDS; KParams k = kp_get(); conv_mla_weights(k->mla_w_in, k->mla_w_out, k->mla_w_qb, k->mla_w_kvb, k->ws, LPV, lds, GW, NGW_, wave, lane); }
                GSYNC(); PT_END(6);
}
template <int lp>
__device__ __forceinline__ void mla_layer(LAS unsigned char* lds, unsigned char* lds_raw, cg::grid_group& grid, int& tidv) { PT_BEGIN(7);
                        PT_BEGIN(8);
            { unsigned char* ws = KP(ws);
              pg8::Gemm g{(const bf16_t*)(ws + WS_ML_H), (const bf16_t*)(ws + WS_ML_WIN), T, 2560, DM, DM, DM, 0}; pg8::StaticOrder S; S.init(T, 2560, (int)gridDim.x, opaque_bid());
              pg8::EpiMlaIn E{(bf16_t*)(ws + WS_ML_SMALL), (bf16_t*)(ws + WS_ML_Z)}; GEMM_CALLN(2); }
            GSYNC(); PT_END(8); PT_BEGIN(9);
            { IDS; KParams k = kp_get(); unsigned char* ws = k->ws;
              mla_norm_rows((const bf16_t*)(ws + WS_ML_SMALL), k->mla_qa_norm + LPV * 256, k->mla_kva_norm + LPV * 128, (const float*)(ws + WS_TAB), (bf16_t*)(ws + WS_ML_QN), (bf16_t*)(ws + WS_ML_KC), GW, NGW_, lane); }
            GSYNC(); PT_END(9); PT_BEGIN(10);
            { unsigned char* ws = KP(ws);
              pg8::Gemm g{(const bf16_t*)(ws + WS_ML_QN), (const bf16_t*)(ws + WS_ML_WQ), T, 3072, 256, 256, 256, 0}; pg8::StaticOrder S; S.init(T, 3072, (int)gridDim.x, opaque_bid(), LPV == 1);
              pg8::EpiQ E{(bf16_t*)(ws + WS_ML_QO), (bf16_t*)(ws + WS_ML_QR)}; GEMM_CALLN(3); }
            GSYNC(); PT_END(10); PT_BEGIN(11);
#ifndef NO_ATT
            { unsigned char* ws = KP(ws); bf16_t* QOb = (bf16_t*)(ws + WS_ML_QO); const bf16_t* QRb = (const bf16_t*)(ws + WS_ML_QR); const bf16_t* KCb = (const bf16_t*)(ws + WS_ML_KC);
              for (int u = opaque_bid(); u < (LPV == 1 ? 2048 : 2048 + 128); u += gridDim.x) {
                int b, h, row0, seq, tq0;
                if (u < 2048) { b = u >> 8; h = (u >> 4) & 15; tq0 = (u & 15) * 256; row0 = b * TPB + CTXL + tq0; seq = TPB; }
                else { const int uc = u - 2048; b = uc >> 4; h = uc & 15; row0 = b * TPB; seq = CTXL; tq0 = -1; }
                att::attn_unit(QOb + (size_t)row0 * DI + h * 128, QRb + (size_t)row0 * 1024 + h * 64, KCb + (size_t)b * TPB * 192, QOb + (size_t)row0 * DI + h * 128, seq, (char*)lds_raw, tq0, (const float*)(ws + WS_TAB), (const bf16_t*)(ws + WS_ML_WVB) + (size_t)h * 128 * 128, (const bf16_t*)(ws + WS_ML_Z) + (size_t)row0 * DI + h * 128, tidv);
              } }
#endif
            GSYNC(); PT_END(11); PT_BEGIN(12);
            PT_BEGIN(13);
            { unsigned char* ws = KP(ws);
              pg8::Gemm g{(const bf16_t*)(ws + WS_ML_QO), (const bf16_t*)(ws + WS_ML_WOUT), T, DM, DI, DI, DI, 0}; pg8::StaticOrder S; S.init(T, DM, (int)gridDim.x, opaque_bid(), LPV == 1);
              pg8::EpiF32 E{(bf16_t*)(ws + WS_ML_Y)}; GEMM_CALLN(5); }
            GSYNC(); PT_END(13); PT_BEGIN(14);
            { IDS; KParams k = kp_get(); unsigned char* ws = k->ws; float* xctx = (float*)(ws + WS_XCTX); const float* mods = (const float*)(ws + WS_MODS);
              postpre_rows(k->out, xctx, k->out, xctx, (const bf16_t*)(ws + WS_ML_Y), mods + (size_t)(2 * LPV + 1) * 9 * 3072, k->norm_post + (2 * LPV + 1) * DM, 0, T, LPV == 0,
                           k->out, xctx, mods + (size_t)(2 * LPV + 2) * 9 * 3072, k->norm_pre + (LPV == 0 ? (2 * LPV + 2) * DM : 0), (bf16_t*)(ws + WS_HG_H), 0, LPV == 0 ? TH : 0, GW, NGW_, lane); }
            if (LPV == 0) { { IDS; KParams k = kp_get(); conv_hgrn_weights(k->hg_w_in, k->hg_w_out, k->ws, 1, lds, GW, NGW_, wave, lane); } GSYNC(); } PT_END(14);
}
__global__ void __launch_bounds__(512, 2) mega_fwd(Params p_unused) {
    extern __shared__ __attribute__((aligned(16))) unsigned char lds_raw[];
    LAS unsigned char* lds = (LAS unsigned char*)lds_raw;
    cg::grid_group grid = cg::this_grid();
    int tidv = threadIdx.x;
    { unsigned* bar_ = (unsigned*)(kp_get()->ws) + 1024;
      if (blockIdx.x == 0) for (int i_ = tidv; i_ < XCD_BAR_WORDS; i_ += 512) __hip_atomic_store(bar_ + i_, 0u, __ATOMIC_RELAXED, __HIP_MEMORY_SCOPE_AGENT);
      if (tidv == 0) { volatile LAS unsigned* st_ = (volatile LAS unsigned*)(lds + 147456 - 64); st_[0] = 0u; st_[1] = 0u; } }
    if (PROBE_ID != 0 && blockIdx.x == 0 && tidv == 0) { ((volatile LAS unsigned long long*)(lds + 147456 - 32))[1] = 0ull; }
    PT_BEGIN(15);

    { IDS; KParams k = kp_get(); mods_phase(k->c, k->c_ctx, k->ada_w, k->ada_b, k->ws, lds, tid); }
    __syncthreads();
    { IDS; KParams k = kp_get(); conv_hgrn_weights(k->hg_w_in, k->hg_w_out, k->ws, 0, lds, GW, NGW_, wave, lane); }
    CGSYNC(); PT_END(15);
    { unsigned* bar_ = (unsigned*)(kp_get()->ws) + 1024; const unsigned xcc_ = xb_xcc_id(); if (tidv == 0) (void)xb_add(bar_ + XB_XCNT(xcc_), 1u); }
    { IDS; KParams k = kp_get(); unsigned char* ws = k->ws;
      postpre_rows(k->x, k->ctx, k->out, (float*)(ws + WS_XCTX), (const bf16_t*)(ws + WS_HG_Y), (const float*)(ws + WS_MODS), k->norm_post, 0, 0, true,
                   k->x, k->ctx, (const float*)(ws + WS_MODS), k->norm_pre, (bf16_t*)(ws + WS_HG_H), 0, TH, GW, NGW_, lane); }
    GSYNC();

    hgrn_pass<0, 0>(lds, lds_raw, grid, tidv); hgrn_pass<0, 1>(lds, lds_raw, grid, tidv);
    mla_layer<0>(lds, lds_raw, grid, tidv);
    hgrn_pass<1, 0>(lds, lds_raw, grid, tidv); hgrn_pass<1, 1>(lds, lds_raw, grid, tidv);
    mla_layer<1>(lds, lds_raw, grid, tidv);
    if (PROBE_ID != 0 && blockIdx.x == 0 && tidv == 0) { const unsigned long long d_ = ((volatile LAS unsigned long long*)(lds + 147456 - 32))[1], t0_ = __builtin_amdgcn_s_memrealtime(); while (__builtin_amdgcn_s_memrealtime() - t0_ < d_) __builtin_amdgcn_s_sleep(8); }
}

extern "C" void kernel_launch(void* const* d_in, const int* in_sizes, int n_in, void* d_out, int out_size, void* d_ws, size_t ws_size, hipStream_t stream) {
    static int grid_blocks = 0;
    if (grid_blocks == 0) {
        if (n_in != 18 || ws_size < 512 * MiB) { fprintf(stderr, "kernel_launch: unexpected n_in %d / ws %zu\n", n_in, ws_size); grid_blocks = -1; return; }
        int dev = 0, cus = 0, per_cu = 0;
        hipGetDevice(&dev);
        hipDeviceGetAttribute(&cus, hipDeviceAttributeMultiprocessorCount, dev);
        if (hipFuncSetAttribute((const void*)mega_fwd, hipFuncAttributeMaxDynamicSharedMemorySize, LDS_BYTES) != hipSuccess) { fprintf(stderr, "kernel_launch: hipFuncSetAttribute failed\n"); grid_blocks = -1; return; }
        if (hipOccupancyMaxActiveBlocksPerMultiprocessor(&per_cu, (const void*)mega_fwd, 512, LDS_BYTES) != hipSuccess || per_cu < 1) { fprintf(stderr, "kernel_launch: occupancy query gave %d\n", per_cu); per_cu = 1; }
        (void)hipGetLastError();
        grid_blocks = cus * per_cu;
    }
    if (grid_blocks < 0) return;
    Params p{};
    p.x = (const float*)d_in[0]; p.c = (const float*)d_in[1]; p.ctx = (const float*)d_in[2]; p.c_ctx = (const float*)d_in[3];
    p.ada_w = (const float*)d_in[4]; p.ada_b = (const float*)d_in[5]; p.norm_pre = (const float*)d_in[6]; p.norm_post = (const float*)d_in[7];
    p.hg_w_in = (const float*)d_in[8]; p.hg_lb = (const float*)d_in[9]; p.hg_o_norm = (const float*)d_in[10]; p.hg_w_out = (const float*)d_in[11];
    p.mla_w_in = (const float*)d_in[12]; p.mla_qa_norm = (const float*)d_in[13]; p.mla_w_qb = (const float*)d_in[14]; p.mla_kva_norm = (const float*)d_in[15];
    p.mla_w_kvb = (const float*)d_in[16]; p.mla_w_out = (const float*)d_in[17];
    p.out = (float*)d_out; p.ws = (unsigned char*)d_ws;
    void* args[] = {&p};
    hipError_t e = hipLaunchCooperativeKernel((const void*)mega_fwd, dim3(grid_blocks), dim3(512), args, LDS_BYTES, stream);
    if (e != hipSuccess) fprintf(stderr, "kernel_launch: cooperative launch failed: %s (grid %d)\n", hipGetErrorString(e), grid_blocks);
}
```

```cpp
#include <hip/hip_runtime.h>
#include <hip/hip_cooperative_groups.h>
#include <cstdio>
#include <cstdint>
namespace cg = cooperative_groups;

#define LAS __attribute__((address_space(3)))
typedef unsigned short bf16_t;
typedef short bf16x8 __attribute__((ext_vector_type(8)));
typedef short s16x4 __attribute__((ext_vector_type(4)));
typedef float f32x4 __attribute__((ext_vector_type(4)));
typedef float f32x2 __attribute__((ext_vector_type(2)));
typedef float f32x16 __attribute__((ext_vector_type(16)));
typedef unsigned u32x4 __attribute__((ext_vector_type(4)));
typedef unsigned u32x2 __attribute__((ext_vector_type(2)));
typedef _Float16 h16x2 __attribute__((ext_vector_type(2)));

constexpr int NB = 8, LAT = 4096, CTXL = 256, TPB = LAT + CTXL  , T = NB * TPB  , TH = T / 2  ;
constexpr int DM = 1024, DI = 2048;
constexpr float EPS = 1e-6f;
constexpr float CQ = 0.07216878364870322f * 1.4426950408889634f;

constexpr size_t MiB = 1u << 20;
constexpr size_t WS_MODS = 64 * 1024;
constexpr size_t WS_TAB = 640 * 1024;
constexpr size_t WS_XCTX = 1 * MiB;
constexpr size_t WS_W = 9 * MiB;
constexpr size_t WS_HG_WIN = WS_W, WS_HG_WOUT = WS_W + 20 * MiB;
constexpr size_t WS_ML_WIN = WS_W, WS_ML_WQ = WS_W + 5 * MiB, WS_ML_WVB = WS_W + 7 * MiB, WS_ML_WOUT = WS_W + 8 * MiB;
constexpr size_t WS_ACT = 35 * MiB;
constexpr size_t HG_ARR = (size_t)TH * DI * 2;
constexpr size_t WS_HG_P = WS_ACT;
constexpr size_t WS_HG_OF = WS_ACT + 5 * HG_ARR, WS_HG_OB = WS_HG_OF + HG_ARR;
constexpr size_t WS_HG_H = WS_HG_OF;
constexpr size_t WS_HG_GATED = WS_HG_P;
constexpr size_t WS_HG_Y = WS_HG_P + HG_ARR;
constexpr size_t WS_ML_H = WS_ACT;
constexpr size_t WS_ML_QR = WS_ACT + 68 * MiB;
constexpr size_t WS_ML_Y = WS_ACT;
constexpr size_t WS_ML_SMALL = WS_ACT + 136 * MiB;
constexpr size_t WS_ML_QN = WS_ACT + 170 * MiB;
constexpr size_t WS_ML_KC = WS_ACT + 187 * MiB;
constexpr size_t WS_ML_Z = WS_ACT + 200 * MiB;
constexpr size_t WS_ML_QO = WS_ACT + 336 * MiB;
static_assert(WS_HG_OB + HG_ARR <= 512 * MiB && WS_ML_QO + 136 * MiB <= 512 * MiB, "ws map");

constexpr int LDS_BYTES = 147456;

typedef __bf16 bf16x2_t __attribute__((ext_vector_type(2)));
__device__ __forceinline__ unsigned cvt_pk_bf16(float lo, float hi) { f32x2 v = {lo, hi}; bf16x2_t b = __builtin_convertvector(v, bf16x2_t); return __builtin_bit_cast(unsigned, b); }
__device__ __forceinline__ unsigned f2bf(float f) { unsigned u = __builtin_bit_cast(unsigned, f); return (u + 0x7fffu + ((u >> 16) & 1u)) >> 16; }
__device__ __forceinline__ float bf2f(unsigned short b) { return __builtin_bit_cast(float, (unsigned)b << 16); }
__device__ __forceinline__ float bflo(unsigned w) { return __builtin_bit_cast(float, w << 16); }
__device__ __forceinline__ float bfhi(unsigned w) { return __builtin_bit_cast(float, w & 0xffff0000u); }
__device__ __forceinline__ unsigned pk_h2(float a, float b) { h16x2 v = {(_Float16)a, (_Float16)b}; return __builtin_bit_cast(unsigned, v); }
__device__ __forceinline__ float silu_f(float x) { return x * __builtin_amdgcn_rcpf(1.f + __expf(-x)); }
__device__ __forceinline__ int opaque_bid() { int b = blockIdx.x; asm volatile("" : "+s"(b)); return b; }
__device__ __forceinline__ int launder_s(int v) { asm volatile("" : "+s"(v)); return v; }
__device__ __forceinline__ int opaque_tid(int& tidv) { asm volatile("" : "+v"(tidv)); return tidv; }
__device__ __forceinline__ float shx(float v, int o, int lane) { return __builtin_bit_cast(float, __builtin_amdgcn_ds_bpermute((lane ^ o) << 2, __builtin_bit_cast(int, v))); }
__device__ __forceinline__ float wave_sum(float v, int lane) {
#pragma unroll
    for (int o = 1; o < 64; o <<= 1) v += shx(v, o, lane);
    return v;
}

namespace pg8 {
constexpr int BM = 256, BK = 64, HALF = 128, HTB = HALF * BK * 2, STAGE_BYTES = 8 * HTB, NXCD = 8, WGM = 4;
__host__ __device__ __forceinline__ int lds_byte(int r, int c) { const int st = (r >> 4) * 2 + (c >> 5), rr = r & 15, cc = c & 31, ob = rr * 64 + cc * 2; return st * 1024 + (ob ^ (((ob >> 9) & 1) << 5)); }
__host__ __device__ __forceinline__ void stage_rc(int b, int& R, int& C) { const int st = b / 1024, sb = b % 1024, swz = sb ^ (((sb >> 9) & 1) << 5); R = (st >> 1) * 16 + swz / 64; C = (st & 1) * 32 + (swz % 64) / 2; }
__host__ __device__ __forceinline__ int perm32(int rho) { const int n = rho >> 4, i = rho & 15; return 8 * (i >> 2) + 4 * n + (i & 3); }
struct Unit { int pm, pn; };
struct Gemm { const bf16_t* A; const bf16_t* Bt; int M, N, K, lda, ldb, acol_pn; };
struct StaticOrder {
    int nM, nN, nwg, G, c, skipctx;
    __device__ void init(int M, int N, int G_, int c_, int skipctx_ = 0) { nM = M / BM; if (skipctx_) nM = nM / 17 * 16; nN = N / BM; nwg = nM * nN; G = G_; c = c_; skipctx = skipctx_; }
    __device__ bool next(int i, Unit& u) const {
        const long L = (long)i * G + c; if (L >= nwg) return false;
        int wgid = (int)L; { const int q = nwg / NXCD, r = nwg % NXCD, xcd = wgid % NXCD, off = wgid / NXCD; wgid = (xcd < r ? xcd * (q + 1) : r * (q + 1) + (xcd - r) * q) + off; }
        const int nig = WGM * nN, gid = wgid / nig, fm = gid * WGM, gsz = (nM - fm) < WGM ? (nM - fm) : WGM;
        u.pm = fm + ((wgid % nig) % gsz); u.pn = (wgid % nig) / gsz; if (skipctx) u.pm = (u.pm >> 4) * 17 + 1 + (u.pm & 15); return true;
    }
};
template <class Epi>
__device__ __forceinline__ void gemm_phase(LAS unsigned char* lds, const Gemm g, const StaticOrder& S, const Epi& E, int& tidv) {
    const int tid = opaque_tid(tidv), wid = __builtin_amdgcn_readfirstlane(tid >> 6), lane = tid & 63, wr = wid >> 2, wc = wid & 3, fr = lane & 15, fq = lane >> 4;
    const int K = g.K, nt = K / BK;
    unsigned voffA[2], voffB[2];
#pragma unroll
    for (int i = 0; i < 2; ++i) { int R, C; stage_rc(tid * 16 + i * 8192, R, C); const int Rb = (R & ~31) + perm32(R & 31);
        voffA[i] = (unsigned)(R * g.lda + C) * 2u; voffB[i] = (unsigned)(Rb * g.ldb + C) * 2u; }
    const unsigned kstep = (unsigned)(BK * 2);
    const unsigned hA = (unsigned)HALF * (unsigned)g.lda * 2u, hB = (unsigned)HALF * (unsigned)g.ldb * 2u;
    const unsigned tA = 2u * hA, tB = 2u * hB;
    const unsigned ldsw = (unsigned)wid * 1024u;
    const int aoff = lds_byte(wr * 64 + fr, fq * 8), boff = lds_byte(wc * 32 + fr, fq * 8);
#define PG8_SA(b, h) (((b) * 2 + (h)) * HTB)
#define PG8_SB(b, h) ((4 + (b) * 2 + (h)) * HTB)
#define PG8_STAGE(bufoff, gbase, voff) do { _Pragma("unroll") for (int _i = 0; _i < 2; ++_i) \
        __builtin_amdgcn_global_load_lds((const unsigned*)((const char*)(gbase) + (voff)[_i]), (LAS unsigned*)(lds + (bufoff) + ldsw + _i * 8192), 16, 0, 0); } while (0)
#define PG8_LDA(dst, b, h) do { _Pragma("unroll") for (int m = 0; m < 4; ++m) _Pragma("unroll") for (int k = 0; k < 2; ++k) dst[m][k] = *(const LAS bf16x8*)(lds + PG8_SA(b, h) + aoff + m * 2048 + k * 1024); } while (0)
#define PG8_LDB(dst, b, h) do { _Pragma("unroll") for (int n = 0; n < 2; ++n) _Pragma("unroll") for (int k = 0; k < 2; ++k) dst[n][k] = *(const LAS bf16x8*)(lds + PG8_SB(b, h) + boff + n * 2048 + k * 1024); } while (0)
#define PG8_MMA(ai, bj, At, Bt) do { __builtin_amdgcn_s_setprio(1); _Pragma("unroll") for (int m = 0; m < 4; ++m) _Pragma("unroll") for (int n = 0; n < 2; ++n) _Pragma("unroll") for (int k = 0; k < 2; ++k) \
        acc[ai][bj][m][n] = __builtin_amdgcn_mfma_f32_16x16x32_bf16(Bt[n][k], At[m][k], acc[ai][bj][m][n], 0, 0, 0); __builtin_amdgcn_s_setprio(0); } while (0)
#define PG8_WAIT_V(n) asm volatile("s_waitcnt vmcnt(" #n ")" ::: "memory")
#define PG8_WAIT_L(n) asm volatile("s_waitcnt lgkmcnt(" #n ")" ::: "memory")
#define PG8_BAR __builtin_amdgcn_s_barrier()
#define PG8_SCHED __builtin_amdgcn_sched_barrier(0)
    Unit cur, nxt; int ui = 0;
    if (!S.next(0, cur)) return;
    f32x4 acc[2][2][4][2];
#pragma unroll
    for (int a = 0; a < 2; ++a)
#pragma unroll
        for (int b = 0; b < 2; ++b)
#pragma unroll
            for (int m = 0; m < 4; ++m)
#pragma unroll
                for (int n = 0; n < 2; ++n) acc[a][b][m][n] = (f32x4){0.f, 0.f, 0.f, 0.f};
    bf16x8 At[4][2], B0[2][2], B1[2][2];
    const char* cA = (const char*)g.A + (size_t)((unsigned)cur.pm * tA + (unsigned)(cur.pn * g.acol_pn * 2)); const char* cB = (const char*)g.Bt + (size_t)((unsigned)cur.pn * tB);
    PG8_STAGE(PG8_SB(0, 0), cB, voffB); PG8_STAGE(PG8_SB(0, 1), cB + hB, voffB); PG8_STAGE(PG8_SA(0, 0), cA, voffA); PG8_STAGE(PG8_SA(0, 1), cA + hA, voffA);
    if (wr == 1) PG8_BAR;
    PG8_WAIT_V(2); PG8_BAR;
    PG8_STAGE(PG8_SB(1, 0), cB + kstep, voffB); PG8_STAGE(PG8_SA(1, 0), cA + kstep, voffA); PG8_STAGE(PG8_SB(1, 1), cB + hB + kstep, voffB);
    PG8_WAIT_V(6); PG8_BAR;
    for (;;) {
        const bool has_next = S.next(ui + 1, nxt);
        const char* nA = has_next ? (const char*)g.A + (size_t)((unsigned)nxt.pm * tA + (unsigned)(nxt.pn * g.acol_pn * 2)) : cA; const char* nB = has_next ? (const char*)g.Bt + (size_t)((unsigned)nxt.pn * tB) : cB;
        for (int t = 0; t < nt; t += 2) {
            const bool last = (t == nt - 2);
            const char* a1 = cA + (unsigned)(t + 1) * kstep;
            const char* a2 = last ? nA : cA + (unsigned)(t + 2) * kstep; const char* b2 = last ? nB : cB + (unsigned)(t + 2) * kstep;
            const char* a3 = a2 + kstep; const char* b3 = b2 + kstep;
            PG8_LDB(B0, 0, 0); PG8_LDB(B1, 0, 1); PG8_SCHED; PG8_LDA(At, 0, 0); PG8_STAGE(PG8_SA(1, 1), a1 + hA, voffA);
            PG8_WAIT_V(8); PG8_WAIT_L(0); PG8_BAR; PG8_MMA(0, 0, At, B0); PG8_MMA(0, 1, At, B1); PG8_BAR; PG8_SCHED;
            PG8_LDA(At, 0, 1); PG8_STAGE(PG8_SB(0, 0), b2, voffB); PG8_STAGE(PG8_SB(0, 1), b2 + hB, voffB); PG8_STAGE(PG8_SA(0, 0), a2, voffA);
            PG8_WAIT_V(8); PG8_WAIT_L(0); PG8_BAR; PG8_MMA(1, 0, At, B0); PG8_MMA(1, 1, At, B1); PG8_BAR; PG8_SCHED;
            PG8_LDB(B0, 1, 0); PG8_LDB(B1, 1, 1); PG8_SCHED; PG8_LDA(At, 1, 0); PG8_STAGE(PG8_SA(0, 1), a2 + hA, voffA);
            PG8_WAIT_V(8); PG8_WAIT_L(0); PG8_BAR; PG8_MMA(0, 0, At, B0); PG8_MMA(0, 1, At, B1); PG8_BAR; PG8_SCHED;
            PG8_LDA(At, 1, 1); PG8_STAGE(PG8_SB(1, 0), b3, voffB); PG8_STAGE(PG8_SB(1, 1), b3 + hB, voffB); PG8_STAGE(PG8_SA(1, 0), a3, voffA);
            PG8_WAIT_V(8); PG8_WAIT_L(0); PG8_BAR; PG8_MMA(1, 0, At, B0); PG8_MMA(1, 1, At, B1); PG8_BAR; PG8_SCHED;
        }
        if (wr == 0) PG8_BAR;
        E(acc, cur, wr, wc, fr, fq);
        if (!has_next) break;
#pragma unroll
        for (int a = 0; a < 2; ++a)
#pragma unroll
            for (int b = 0; b < 2; ++b)
#pragma unroll
                for (int m = 0; m < 4; ++m)
#pragma unroll
                    for (int n = 0; n < 2; ++n) acc[a][b][m][n] = (f32x4){0.f, 0.f, 0.f, 0.f};
        cur = nxt; cA = nA; cB = nB; ++ui;
        if (wr == 1) PG8_BAR;
    }
    PG8_WAIT_V(0);
    PG8_BAR;
#undef PG8_SA
#undef PG8_SB
#undef PG8_STAGE
#undef PG8_LDA
#undef PG8_LDB
#undef PG8_MMA
#undef PG8_WAIT_V
#undef PG8_WAIT_L
#undef PG8_BAR
#undef PG8_SCHED
}

typedef f32x4 Acc[2][2][4][2];
struct EpiHgIn {
    bf16_t* base;
    __device__ __forceinline__ void operator()(const Acc& acc, const Unit& u, int wr, int wc, int fr, int fq) const {
        const int which = u.pn >> 3, colt = (u.pn & 7) * 256;
        bf16_t* ob = base + (size_t)which * ((size_t)TH * DI);
        const int row0 = u.pm * 256 + wr * 64 + fr, col0 = colt + wc * 32 + 8 * fq;
#pragma unroll
        for (int ai = 0; ai < 2; ++ai)
#pragma unroll
            for (int m = 0; m < 4; ++m) { bf16_t* rowp = ob + (size_t)(row0 + ai * 128 + m * 16) * DI + col0;
#pragma unroll
                for (int bj = 0; bj < 2; ++bj) { f32x4 v0 = acc[ai][bj][m][0], v1 = acc[ai][bj][m][1]; u32x4 w;
                    if (which == 0) {
#pragma unroll
                        for (int e = 0; e < 4; ++e) { v0[e] = silu_f(v0[e]); v1[e] = silu_f(v1[e]); } }
                    if (which == 2 || which == 3) { w.x = pk_h2(v0[0], v0[1]); w.y = pk_h2(v0[2], v0[3]); w.z = pk_h2(v1[0], v1[1]); w.w = pk_h2(v1[2], v1[3]); }
                    else { w.x = cvt_pk_bf16(v0[0], v0[1]); w.y = cvt_pk_bf16(v0[2], v0[3]); w.z = cvt_pk_bf16(v1[0], v1[1]); w.w = cvt_pk_bf16(v1[2], v1[3]); }
                    *(u32x4*)(rowp + bj * 128) = w; } }
    }
};
struct EpiF32 {
    bf16_t* out;
    __device__ __forceinline__ void operator()(const Acc& acc, const Unit& u, int wr, int wc, int fr, int fq) const {
        const int row0 = u.pm * 256 + wr * 64 + fr, col0 = u.pn * 256 + wc * 32 + 8 * fq;
#pragma unroll
        for (int ai = 0; ai < 2; ++ai)
#pragma unroll
            for (int m = 0; m < 4; ++m) { bf16_t* rowp = out + (size_t)(row0 + ai * 128 + m * 16) * DM + col0;
#pragma unroll
                for (int bj = 0; bj < 2; ++bj) { const f32x4 v0 = acc[ai][bj][m][0], v1 = acc[ai][bj][m][1]; u32x4 w;
                    w.x = cvt_pk_bf16(v0[0], v0[1]); w.y = cvt_pk_bf16(v0[2], v0[3]); w.z = cvt_pk_bf16(v1[0], v1[1]); w.w = cvt_pk_bf16(v1[2], v1[3]);
                    *(u32x4*)(rowp + bj * 128) = w; } }
    }
};
struct EpiMlaIn {
    bf16_t* small; bf16_t* z;
    __device__ __forceinline__ void operator()(const Acc& acc, const Unit& u, int wr, int wc, int fr, int fq) const {
        const bool sm = u.pn < 2; bf16_t* ob = sm ? small : z; const int ld = sm ? 512 : DI;
        const int row0 = u.pm * 256 + wr * 64 + fr, col0 = (sm ? u.pn : u.pn - 2) * 256 + wc * 32 + 8 * fq;
#pragma unroll
        for (int ai = 0; ai < 2; ++ai)
#pragma unroll
            for (int m = 0; m < 4; ++m) { bf16_t* rowp = ob + (size_t)(row0 + ai * 128 + m * 16) * ld + col0;
#pragma unroll
                for (int bj = 0; bj < 2; ++bj) { const f32x4 v0 = acc[ai][bj][m][0], v1 = acc[ai][bj][m][1]; u32x4 w;
                    w.x = cvt_pk_bf16(v0[0], v0[1]); w.y = cvt_pk_bf16(v0[2], v0[3]); w.z = cvt_pk_bf16(v1[0], v1[1]); w.w = cvt_pk_bf16(v1[2], v1[3]);
                    *(u32x4*)(rowp + bj * 128) = w; } }
    }
};
struct EpiQ {
    bf16_t* qn; bf16_t* qr;
    __device__ __forceinline__ void operator()(const Acc& acc, const Unit& u, int wr, int wc, int fr, int fq) const {
        const bool nope = u.pn < 8; bf16_t* ob = nope ? qn : qr; const int ld = nope ? DI : 1024;
        const int row0 = u.pm * 256 + wr * 64 + fr, col0 = (nope ? u.pn : u.pn - 8) * 256 + wc * 32 + 8 * fq;
#pragma unroll
        for (int ai = 0; ai < 2; ++ai)
#pragma unroll
            for (int m = 0; m < 4; ++m) { bf16_t* rowp = ob + (size_t)(row0 + ai * 128 + m * 16) * ld + col0;
#pragma unroll
                for (int bj = 0; bj < 2; ++bj) { const f32x4 v0 = acc[ai][bj][m][0] * CQ, v1 = acc[ai][bj][m][1] * CQ; u32x4 w;
                    w.x = cvt_pk_bf16(v0[0], v0[1]); w.y = cvt_pk_bf16(v0[2], v0[3]); w.z = cvt_pk_bf16(v1[0], v1[1]); w.w = cvt_pk_bf16(v1[2], v1[3]);
                    *(u32x4*)(rowp + bj * 128) = w; } }
    }
};
struct EpiVb {
    bf16_t* out; const bf16_t* z;
    __device__ __forceinline__ void operator()(const Acc& acc, const Unit& u, int wr, int wc, int fr, int fq) const {
        const int row0 = u.pm * 256 + wr * 64 + fr, col0 = u.pn * 256 + wc * 32 + 8 * fq;
#pragma unroll
        for (int ai = 0; ai < 2; ++ai)
#pragma unroll
            for (int m = 0; m < 4; ++m) { const size_t off = (size_t)(row0 + ai * 128 + m * 16) * DI + col0;
#pragma unroll
                for (int bj = 0; bj < 2; ++bj) { const f32x4 v0 = acc[ai][bj][m][0], v1 = acc[ai][bj][m][1]; const u32x4 zz = *(const u32x4*)(z + off + bj * 128); u32x4 w;
                    w.x = cvt_pk_bf16(v0[0] * silu_f(bflo(zz.x)), v0[1] * silu_f(bfhi(zz.x))); w.y = cvt_pk_bf16(v0[2] * silu_f(bflo(zz.y)), v0[3] * silu_f(bfhi(zz.y)));
                    w.z = cvt_pk_bf16(v1[0] * silu_f(bflo(zz.z)), v1[1] * silu_f(bfhi(zz.z))); w.w = cvt_pk_bf16(v1[2] * silu_f(bflo(zz.w)), v1[3] * silu_f(bfhi(zz.w)));
                    *(u32x4*)(out + off + bj * 128) = w; } }
    }
};
}

namespace att {
constexpr int NW = 8, QBLK = 32, KVBLK = 64;
constexpr int SHM_V = 16384, SHM_KN = 16384, SHM_KR = 8192;
constexpr int NBUF = 3, OFF_V = 0, OFF_KN = NBUF * SHM_V, OFF_KR = OFF_KN + NBUF * SHM_KN, OFF_WS = OFF_KR + NBUF * SHM_KR, SHM_ATTN = OFF_WS + NW * 64 * 4;
static_assert(SHM_ATTN <= 131072, "attention LDS");
constexpr float THR2 = 11.0f;
#define KSWZ(row, colB) ((row) * 256 + ((colB) ^ (((row) & 15) << 4)))
#define KRSWZ(row, colB) ((row) * 128 + ((colB) ^ ((((row) >> 1) & 7) << 4)))
#define SBAR() __builtin_amdgcn_sched_barrier(0)
__device__ __forceinline__ int crow(int r, int hi) { return (r & 3) + 8 * (r >> 2) + 4 * hi; }
__device__ __forceinline__ void partialSM(f32x16& p0, f32x16& p1, float& m_reg, float& mn, float& alpha) {
    float pmax = p0[0];
#pragma unroll
    for (int r = 1; r < 16; ++r) pmax = fmaxf(pmax, p0[r]);
#pragma unroll
    for (int r = 0; r < 16; ++r) pmax = fmaxf(pmax, p1[r]);
    { auto rr = __builtin_amdgcn_permlane32_swap(__float_as_uint(pmax), __float_as_uint(pmax), false, false);
      pmax = fmaxf(__uint_as_float(rr[0]), __uint_as_float(rr[1])); }
    if (__builtin_expect(__all(pmax - m_reg <= THR2), 1)) { mn = m_reg; alpha = 1.f; }
    else { mn = fmaxf(m_reg, pmax); alpha = __builtin_amdgcn_exp2f(m_reg - mn); m_reg = mn; }
#pragma unroll
    for (int r = 0; r < 16; ++r) p0[r] = p0[r] - mn;
#pragma unroll
    for (int r = 0; r < 16; ++r) p1[r] = p1[r] - mn;
#pragma unroll
    for (int r = 0; r < 16; ++r) p0[r] = __builtin_amdgcn_exp2f(p0[r]);
}
__device__ __forceinline__ void finishSM(f32x16& p0, f32x16& p1, float alpha, float& l_reg, bf16x8& pa0, bf16x8& pa1, bf16x8& pa2, bf16x8& pa3) {
#pragma unroll
    for (int r = 0; r < 16; ++r) p1[r] = __builtin_amdgcn_exp2f(p1[r]);
    float ps = 0;
#pragma unroll
    for (int r = 0; r < 16; ++r) ps += p0[r];
#pragma unroll
    for (int r = 0; r < 16; ++r) ps += p1[r];
    { auto rr = __builtin_amdgcn_permlane32_swap(__float_as_uint(ps), __float_as_uint(ps), false, false);
      ps = __uint_as_float(rr[0]) + __uint_as_float(rr[1]); }
    l_reg = l_reg * alpha + ps;
#define PK4(P, BASE, OUT) do { unsigned a0 = cvt_pk_bf16(P[BASE + 0], P[BASE + 1]), a1 = cvt_pk_bf16(P[BASE + 2], P[BASE + 3]);   \
    unsigned b0 = cvt_pk_bf16(P[BASE + 4], P[BASE + 5]), b1 = cvt_pk_bf16(P[BASE + 6], P[BASE + 7]);                              \
    auto r0 = __builtin_amdgcn_permlane32_swap(a0, b0, false, false); auto r1 = __builtin_amdgcn_permlane32_swap(a1, b1, false, false); \
    u32x4 w = {r0[0], r1[0], r0[1], r1[1]}; OUT = *reinterpret_cast<bf16x8*>(&w); } while (0)
    PK4(p0, 0, pa0); PK4(p0, 8, pa1); PK4(p1, 0, pa2); PK4(p1, 8, pa3);
#undef PK4
}
__device__ __forceinline__ void qkt(f32x16& p0, f32x16& p1, const char* Kn, const char* Kr, const bf16x8* qr, int r32, int hi) {
    p0 = f32x16{}; p1 = f32x16{};
#pragma unroll
    for (int d0 = 0; d0 < 8; ++d0) { const int cb = (d0 * 16 + hi * 8) * 2;
        const bf16x8 b0 = *reinterpret_cast<const bf16x8*>(Kn + KSWZ(r32, cb));
        const bf16x8 b1 = *reinterpret_cast<const bf16x8*>(Kn + KSWZ(32 + r32, cb));
        p0 = __builtin_amdgcn_mfma_f32_32x32x16_bf16(b0, qr[d0], p0, 0, 0, 0);
        p1 = __builtin_amdgcn_mfma_f32_32x32x16_bf16(b1, qr[d0], p1, 0, 0, 0); }
#pragma unroll
    for (int d0 = 0; d0 < 4; ++d0) { const int cb = (d0 * 16 + hi * 8) * 2;
        const bf16x8 b0 = *reinterpret_cast<const bf16x8*>(Kr + KRSWZ(r32, cb));
        const bf16x8 b1 = *reinterpret_cast<const bf16x8*>(Kr + KRSWZ(32 + r32, cb));
        p0 = __builtin_amdgcn_mfma_f32_32x32x16_bf16(b0, qr[8 + d0], p0, 0, 0, 0);
        p1 = __builtin_amdgcn_mfma_f32_32x32x16_bf16(b1, qr[8 + d0], p1, 0, 0, 0); }
}
__device__ __forceinline__ int v_st(int k, int c) { const int kk = (k & ~0xC) | ((k & 4) << 1) | ((k & 8) >> 1); return ((kk >> 3) * 4 + (c >> 5)) * 512 + ((kk & 7) * 32 + (c & 31)) * 2; }
__device__ __forceinline__ int v_rd_base(int lane) { return ((lane & 3) << 3) | (((lane >> 2) & 3) << 6) | (((lane >> 4) & 1) << 5) | (((lane >> 5) & 1) << 8); }
constexpr int v_rd_off(int d0, int ks, int half) { return d0 * 512 + ks * 4096 + half * 2048; }
template <int OFF> __device__ __forceinline__ s16x4 tr_read(int vb) {
    s16x4 r; asm volatile("ds_read_b64_tr_b16 %0, %1 offset:%2" : "=&v"(r) : "v"(vb), "i"(OFF) : "memory"); return r;
}
template <int D0> __device__ __forceinline__ void pv_one(f32x16& od, int vb, bf16x8 pa0, bf16x8 pa1, bf16x8 pa2, bf16x8 pa3) {
    const s16x4 l0 = tr_read<v_rd_off(D0, 0, 0)>(vb), h0 = tr_read<v_rd_off(D0, 0, 1)>(vb), l1 = tr_read<v_rd_off(D0, 1, 0)>(vb), h1 = tr_read<v_rd_off(D0, 1, 1)>(vb);
    const s16x4 l2 = tr_read<v_rd_off(D0, 2, 0)>(vb), h2 = tr_read<v_rd_off(D0, 2, 1)>(vb), l3 = tr_read<v_rd_off(D0, 3, 0)>(vb), h3 = tr_read<v_rd_off(D0, 3, 1)>(vb);
    asm volatile("s_waitcnt lgkmcnt(0)" ::: "memory"); SBAR();
#define PK(L, H) (bf16x8){L[0], L[1], L[2], L[3], H[0], H[1], H[2], H[3]}
    od = __builtin_amdgcn_mfma_f32_32x32x16_bf16(pa0, PK(l0, h0), od, 0, 0, 0);
    od = __builtin_amdgcn_mfma_f32_32x32x16_bf16(pa1, PK(l1, h1), od, 0, 0, 0);
    od = __builtin_amdgcn_mfma_f32_32x32x16_bf16(pa2, PK(l2, h2), od, 0, 0, 0);
    od = __builtin_amdgcn_mfma_f32_32x32x16_bf16(pa3, PK(l3, h3), od, 0, 0, 0);
#undef PK
}
__device__ __forceinline__ void pv_d0(f32x16* o, int vb, bf16x8 pa0, bf16x8 pa1, bf16x8 pa2, bf16x8 pa3) {
    pv_one<0>(o[0], vb, pa0, pa1, pa2, pa3); pv_one<1>(o[1], vb, pa0, pa1, pa2, pa3); pv_one<2>(o[2], vb, pa0, pa1, pa2, pa3); pv_one<3>(o[3], vb, pa0, pa1, pa2, pa3);
}
__device__ __forceinline__ void attn_unit(const bf16_t* Qn, const bf16_t* Qr, const bf16_t* __restrict__ Kh, bf16_t* Ob, int seq, char* lds, int tq0  , const float* tab, const bf16_t* __restrict__ Wv  , const bf16_t* __restrict__ Zr  , int& tidv) {
    const int tid = opaque_tid(tidv), wid = tid >> 6, lane = tid & 63, r32 = lane & 31, hi = lane >> 5;
    char* V_lds = lds + OFF_V; char* KN_lds = lds + OFF_KN; char* KR_lds = lds + OFF_KR;
    float* ws = (float*)(lds + OFF_WS) + wid * 64; float* li_l = ws; float* al_l = ws + 32;
    float m_reg = -1e30f, l_reg = 0; f32x16 o[4] = {}; bf16x8 qr[12];
    { const bf16_t* Qw = Qn + (long)(wid * QBLK + r32) * DI + hi * 8;
#pragma unroll
      for (int d0 = 0; d0 < 8; ++d0) qr[d0] = *reinterpret_cast<const bf16x8*>(Qw + d0 * 16);
      const bf16_t* Qw2 = Qr + (long)(wid * QBLK + r32) * 1024 + hi * 8;
#pragma unroll
      for (int d0 = 0; d0 < 4; ++d0) qr[8 + d0] = *reinterpret_cast<const bf16x8*>(Qw2 + d0 * 16);
      if (tq0 >= 0) { const int t = tq0 + wid * QBLK + r32;
#pragma unroll
        for (int d0 = 0; d0 < 4; ++d0) { const int pos = d0 < 2 ? (t >> 6) : (t & 63); const float* tp = tab + (pos * 16 + (d0 & 1) * 8 + hi * 4) * 2;
            const f32x4 c0 = *(const f32x4*)tp, c1 = *(const f32x4*)(tp + 4); const u32x4 q = __builtin_bit_cast(u32x4, qr[8 + d0]); u32x4 w;
            { const float a = bflo(q.x), b = bfhi(q.x); w.x = cvt_pk_bf16(a * c0[0] - b * c0[1], a * c0[1] + b * c0[0]); }
            { const float a = bflo(q.y), b = bfhi(q.y); w.y = cvt_pk_bf16(a * c0[2] - b * c0[3], a * c0[3] + b * c0[2]); }
            { const float a = bflo(q.z), b = bfhi(q.z); w.z = cvt_pk_bf16(a * c1[0] - b * c1[1], a * c1[1] + b * c1[0]); }
            { const float a = bflo(q.w), b = bfhi(q.w); w.w = cvt_pk_bf16(a * c1[2] - b * c1[3], a * c1[3] + b * c1[2]); }
            qr[8 + d0] = __builtin_bit_cast(bf16x8, w); } } }
    const int sr = tid >> 4, sc = (tid & 15) * 8, vst0 = v_st(sr, sc), vst1 = v_st(32 + sr, sc);
    const int rr_ = tid >> 3, rc = (tid & 7) * 8;
    const int vb0 = (int)(uintptr_t)V_lds + v_rd_base(lane);
    struct { bf16x8 ks0, ks1, kr; } sr_[1];
#define SLOAD(i, k0) do { sr_[i].ks0 = *reinterpret_cast<const bf16x8*>(&Kh[(long)((k0) + sr) * 192 + sc]); sr_[i].ks1 = *reinterpret_cast<const bf16x8*>(&Kh[(long)((k0) + 32 + sr) * 192 + sc]); \
    sr_[i].kr = *reinterpret_cast<const bf16x8*>(&Kh[(long)((k0) + rr_) * 192 + 128 + rc]); } while (0)
#define SWRITE(b, i) do { *(bf16x8*)(V_lds + (b) * SHM_V + vst0) = sr_[i].ks0; *(bf16x8*)(V_lds + (b) * SHM_V + vst1) = sr_[i].ks1; const int kc = sc * 2; \
    *(bf16x8*)(KN_lds + (b) * SHM_KN + KSWZ(sr, kc)) = sr_[i].ks0; *(bf16x8*)(KN_lds + (b) * SHM_KN + KSWZ(32 + sr, kc)) = sr_[i].ks1; \
    *(bf16x8*)(KR_lds + (b) * SHM_KR + KRSWZ(rr_, rc * 2)) = sr_[i].kr; } while (0)
#define SWAIT() asm volatile("s_waitcnt vmcnt(0)" ::: "memory")
#define RESC(a) do { if (__any((a) < 1.f)) { if (hi == 0) al_l[r32] = (a); asm volatile("s_waitcnt lgkmcnt(0)" ::: "memory"); \
    _Pragma("unroll") for (int d = 0; d < 4; ++d) _Pragma("unroll") for (int r = 0; r < 16; ++r) o[d][r] *= al_l[crow(r, hi)]; } } while (0)
    f32x16 pA0, pA1, pB0, pB1; float mnA, mnB, alA, alB; bf16x8 pa0, pa1, pa2, pa3; const int NT = seq / KVBLK;
    SLOAD(0, 0); asm volatile("s_waitcnt vmcnt(0)" ::: "memory"); SWRITE(0, 0); __syncthreads();
    qkt(pA0, pA1, KN_lds, KR_lds, qr, r32, hi); partialSM(pA0, pA1, m_reg, mnA, alA);
    SLOAD(0, KVBLK);
    SWAIT(); SWRITE(1, 0); if (2 < NT) SLOAD(0, 2 * KVBLK); __syncthreads();
    int bp = 0, bc = 1, bn = 2;
#define ROT3() do { bp = bc; bc = bn; bn = (bn == NBUF - 1) ? 0 : bn + 1; } while (0)
    for (int t = 1; t + 1 < NT; t += 2) {
        SBAR(); qkt(pB0, pB1, KN_lds + bc * SHM_KN, KR_lds + bc * SHM_KR, qr, r32, hi);
        finishSM(pA0, pA1, alA, l_reg, pa0, pa1, pa2, pa3); SBAR();
        pv_d0(o, vb0 + bp * SHM_V, pa0, pa1, pa2, pa3); partialSM(pB0, pB1, m_reg, mnB, alB);
        SWAIT(); SWRITE(bn, 0); SBAR();
        if (t + 2 < NT) SLOAD(0, (t + 2) * KVBLK); SBAR();
        RESC(alB); __syncthreads(); ROT3();
        SBAR(); qkt(pA0, pA1, KN_lds + bc * SHM_KN, KR_lds + bc * SHM_KR, qr, r32, hi);
        finishSM(pB0, pB1, alB, l_reg, pa0, pa1, pa2, pa3); SBAR();
        pv_d0(o, vb0 + bp * SHM_V, pa0, pa1, pa2, pa3); partialSM(pA0, pA1, m_reg, mnA, alA);
        if (t + 2 < NT) { SWAIT(); SWRITE(bn, 0); } SBAR();
        if (t + 3 < NT) SLOAD(0, (t + 3) * KVBLK); SBAR();
        RESC(alA); __syncthreads(); ROT3();
    }
    SBAR(); qkt(pB0, pB1, KN_lds + bc * SHM_KN, KR_lds + bc * SHM_KR, qr, r32, hi);
    finishSM(pA0, pA1, alA, l_reg, pa0, pa1, pa2, pa3); SBAR();
    pv_d0(o, vb0 + bp * SHM_V, pa0, pa1, pa2, pa3); partialSM(pB0, pB1, m_reg, mnB, alB);
    RESC(alB);
    finishSM(pB0, pB1, alB, l_reg, pa0, pa1, pa2, pa3); SBAR();
    pv_d0(o, vb0 + bc * SHM_V, pa0, pa1, pa2, pa3);
#undef ROT3
    if (hi == 0) li_l[r32] = l_reg; asm volatile("s_waitcnt lgkmcnt(0)" ::: "memory");
    float rli[16];
#pragma unroll
    for (int r = 0; r < 16; ++r) rli[r] = __builtin_amdgcn_rcpf(li_l[crow(r, hi)]);
    __syncthreads();
    { const int row = tid >> 2, c4 = (tid & 3) * 32; const u32x4* src = (const u32x4*)(Wv + (size_t)row * 128 + c4);
      const u32x4 a0 = src[0], a1 = src[1], a2 = src[2], a3 = src[3]; char* dst = lds + row * 272 + c4 * 2;
      *(u32x4*)dst = a0; *(u32x4*)(dst + 16) = a1; *(u32x4*)(dst + 32) = a2; *(u32x4*)(dst + 48) = a3; }
    char* os = lds + 34816 + wid * 8704;
#pragma unroll
    for (int r = 0; r < 16; ++r) { const int orow = crow(r, hi);
#pragma unroll
        for (int d0 = 0; d0 < 4; ++d0) *(bf16_t*)(os + orow * 272 + (d0 * 32 + r32) * 2) = (bf16_t)f2bf(o[d0][r] * rli[r]); }
    __syncthreads();
    f32x16 gacc[4] = {};
#pragma unroll
    for (int ks = 0; ks < 8; ++ks) { const bf16x8 A = *reinterpret_cast<const bf16x8*>(os + r32 * 272 + (ks * 16 + hi * 8) * 2);
#pragma unroll
        for (int nb = 0; nb < 4; ++nb) { const bf16x8 Bv = *reinterpret_cast<const bf16x8*>(lds + (nb * 32 + r32) * 272 + (ks * 16 + hi * 8) * 2);
            gacc[nb] = __builtin_amdgcn_mfma_f32_32x32x16_bf16(A, Bv, gacc[nb], 0, 0, 0); } }
#pragma unroll
    for (int r = 0; r < 16; ++r) { const int orow = crow(r, hi);
#pragma unroll
        for (int nb = 0; nb < 4; ++nb) *(bf16_t*)(os + orow * 272 + (nb * 32 + r32) * 2) = (bf16_t)(cvt_pk_bf16(gacc[nb][r], 0.f) & 0xffffu); }
    bf16_t* Ow = Ob + (long)(wid * QBLK) * DI; const bf16_t* Zw = Zr + (long)(wid * QBLK) * DI;
#pragma unroll
    for (int i = 0; i < 8; ++i) { const int row = i * 4 + (lane >> 4), ch = lane & 15;
        const u32x4 v = *reinterpret_cast<const u32x4*>(os + row * 272 + ch * 16); const u32x4 zz = *(const u32x4*)(Zw + (long)row * DI + ch * 8); u32x4 w;
        w.x = cvt_pk_bf16(bflo(v.x) * silu_f(bflo(zz.x)), bfhi(v.x) * silu_f(bfhi(zz.x))); w.y = cvt_pk_bf16(bflo(v.y) * silu_f(bflo(zz.y)), bfhi(v.y) * silu_f(bfhi(zz.y)));
        w.z = cvt_pk_bf16(bflo(v.z) * silu_f(bflo(zz.z)), bfhi(v.z) * silu_f(bfhi(zz.z))); w.w = cvt_pk_bf16(bflo(v.w) * silu_f(bflo(zz.w)), bfhi(v.w) * silu_f(bfhi(zz.w)));
        *(u32x4*)(Ow + (long)row * DI + ch * 8) = w; }
    __syncthreads();
#undef SLOAD
#undef SWRITE
#undef SWAIT
#undef RESC
}
}

struct Params {
    const float *x, *c, *ctx, *c_ctx, *ada_w, *ada_b, *norm_pre, *norm_post, *hg_w_in, *hg_lb, *hg_o_norm, *hg_w_out,
                *mla_w_in, *mla_qa_norm, *mla_w_qb, *mla_kva_norm, *mla_w_kvb, *mla_w_out;
    float* out; unsigned char* ws;
};

__device__ __forceinline__ void transpose_item(const float* W, int ldw, int src_n0, int k0, bf16_t* WT, int ldt, int dst_row0, LAS float* scr, int lane) {
    f32x4 v[8];
#pragma unroll
    for (int i = 0; i < 8; ++i) { const int kk = 8 * i + (lane >> 3); v[i] = src_n0 >= 0 ? *(const f32x4*)(W + (size_t)(k0 + kk) * ldw + src_n0 + (lane & 7) * 4) : (f32x4){0.f, 0.f, 0.f, 0.f}; }
#pragma unroll
    for (int i = 0; i < 8; ++i) { const int kk = 8 * i + (lane >> 3); LAS float* d = scr + kk * 33 + (lane & 7) * 4; d[0] = v[i][0]; d[1] = v[i][1]; d[2] = v[i][2]; d[3] = v[i][3]; }
    asm volatile("s_waitcnt lgkmcnt(0)" ::: "memory");
    const int c = lane & 7;
#pragma unroll
    for (int j = 0; j < 4; ++j) { const int n = (lane >> 3) + 8 * j; const LAS float* s = scr + (8 * c) * 33 + n;
        u32x4 o; o.x = cvt_pk_bf16(s[0 * 33], s[1 * 33]); o.y = cvt_pk_bf16(s[2 * 33], s[3 * 33]); o.z = cvt_pk_bf16(s[4 * 33], s[5 * 33]); o.w = cvt_pk_bf16(s[6 * 33], s[7 * 33]);
        *(u32x4*)(WT + (size_t)(dst_row0 + n) * ldt + k0 + 8 * c) = o; }
    asm volatile("s_waitcnt lgkmcnt(0)" ::: "memory");
}
__device__ __forceinline__ void conv_hgrn_weights(const float* hg_w_in, const float* hg_w_out, unsigned char* ws, int j, LAS unsigned char* lds, int gw, int NGW, int wave, int lane) {
    LAS float* scr = (LAS float*)(lds + wave * 16384);
    const float* win = hg_w_in + (size_t)j * DM * 10240; const float* wout = hg_w_out + (size_t)j * DI * DM;
    bf16_t* win_t = (bf16_t*)(ws + WS_HG_WIN); bf16_t* wout_t = (bf16_t*)(ws + WS_HG_WOUT);
    constexpr int I_IN = 16 * 320, I_OUT = 32 * 32;
    for (int it = gw; it < I_IN + I_OUT; it += NGW) {
        if (it < I_IN) { const int kb = it / 320, nb = it % 320; transpose_item(win, 10240, nb * 32, kb * 64, win_t, DM, nb * 32, scr, lane); }
        else { const int r = it - I_IN, kb = r / 32, nb = r % 32; transpose_item(wout, DM, nb * 32, kb * 64, wout_t, DI, nb * 32, scr, lane); }
    }
}
__device__ __forceinline__ void conv_mla_weights(const float* mla_w_in, const float* mla_w_out, const float* mla_w_qb, const float* mla_w_kvb, unsigned char* ws, int j, LAS unsigned char* lds, int gw, int NGW, int wave, int lane) {
    LAS float* scr = (LAS float*)(lds + wave * 16384);
    const float* win = mla_w_in + (size_t)j * DM * 2496; const float* wout = mla_w_out + (size_t)j * DI * DM;
    const float* wqb = mla_w_qb + (size_t)j * 256 * 3072; const float* wkvb = mla_w_kvb + (size_t)j * 128 * 4096;
    bf16_t* win_t = (bf16_t*)(ws + WS_ML_WIN); bf16_t* wout_t = (bf16_t*)(ws + WS_ML_WOUT);
    bf16_t* wq_t = (bf16_t*)(ws + WS_ML_WQ); bf16_t* wvb_t = (bf16_t*)(ws + WS_ML_WVB);
    constexpr int I_IN = 16 * 80, I_OUT = 32 * 32;
    for (int it = gw; it < I_IN + I_OUT; it += NGW) {
        if (it < I_IN) { const int kb = it / 80, nb = it % 80; const int src = nb < 14 ? nb * 32 : (nb < 16 ? -1 : nb * 32 - 64);
            transpose_item(win, 2496, src, kb * 64, win_t, DM, nb * 32, scr, lane); }
        else { const int r = it - I_IN, kb = r / 32, nb = r % 32; transpose_item(wout, DM, nb * 32, kb * 64, wout_t, DI, nb * 32, scr, lane); }
    }
    const int gt = gw * 64 + lane, NGT = NGW * 64;
    for (int idx = gt; idx < 2048 * 64; idx += NGT) { const int r0 = (idx & 63) * 4, n = idx >> 6, h = n >> 7, c = n & 127;
        const f32x4* kv = (const f32x4*)(wkvb + (size_t)c * 4096 + h * 256); float a[4] = {0.f, 0.f, 0.f, 0.f};
        for (int d4 = 0; d4 < 32; ++d4) { const f32x4 kk = kv[d4];
#pragma unroll
            for (int e = 0; e < 4; ++e) { const f32x4 q = *(const f32x4*)(wqb + (size_t)(r0 + e) * 3072 + h * 192 + d4 * 4); a[e] += q[0] * kk[0] + q[1] * kk[1] + q[2] * kk[2] + q[3] * kk[3]; } }
        u32x2 w; w.x = cvt_pk_bf16(a[0], a[1]); w.y = cvt_pk_bf16(a[2], a[3]); *(u32x2*)(wq_t + (size_t)n * 256 + r0) = w; }
    for (int idx = gt; idx < 1024 * 64; idx += NGT) { const int r0 = (idx & 63) * 4, nn = idx >> 6, h = nn >> 6, jj = (nn & 63) >> 1, e = nn & 1; const int col = h * 192 + 128 + jj + 32 * e;
        u32x2 w; w.x = cvt_pk_bf16(wqb[(size_t)r0 * 3072 + col], wqb[(size_t)(r0 + 1) * 3072 + col]); w.y = cvt_pk_bf16(wqb[(size_t)(r0 + 2) * 3072 + col], wqb[(size_t)(r0 + 3) * 3072 + col]);
        *(u32x2*)(wq_t + (size_t)(2048 + nn) * 256 + r0) = w; }
    for (int idx = gt; idx < 2048 * 32; idx += NGT) { const int k0 = (idx & 31) * 4, hn = idx >> 5, h = hn >> 7, n = hn & 127; const int col = h * 256 + 128 + n;
        u32x2 w; w.x = cvt_pk_bf16(wkvb[(size_t)k0 * 4096 + col], wkvb[(size_t)(k0 + 1) * 4096 + col]); w.y = cvt_pk_bf16(wkvb[(size_t)(k0 + 2) * 4096 + col], wkvb[(size_t)(k0 + 3) * 4096 + col]);
        *(u32x2*)(wvb_t + (size_t)hn * 128 + k0) = w; }
}
__device__ __forceinline__ void mods_phase(const float* pc, const float* pcc, const float* ada_w, const float* ada_b, unsigned char* ws, LAS unsigned char* lds, int tid) {
    LAS float* sc = (LAS float*)lds;
    LAS float* red = (LAS float*)(lds + 36864);
    for (int i = tid; i < 9 * 1024; i += 512) { const float v = i < 8192 ? pc[i] : pcc[i - 8192]; sc[i] = silu_f(v); }
    __syncthreads();
    float* mods = (float*)(ws + WS_MODS);
    const int col = tid % 48, kg = tid / 48;
    for (int item = blockIdx.x; item < 4 * 64; item += gridDim.x) {
        const int layer = item >> 6, n0 = (item & 63) * 48;
        if (kg < 10) {
            const float* w = ada_w + (size_t)layer * DM * 3072 + n0 + col;
            float a[9];
#pragma unroll
            for (int q = 0; q < 9; ++q) a[q] = 0.f;
#pragma unroll 16
            for (int k = kg; k < DM; k += 10) { const float wv = w[(size_t)k * 3072];
#pragma unroll
                for (int q = 0; q < 9; ++q) a[q] += sc[q * 1024 + k] * wv; }
#pragma unroll
            for (int q = 0; q < 9; ++q) red[(kg * 9 + q) * 48 + col] = a[q];
        }
        __syncthreads();
        if (tid < 432) { const int q = tid / 48, cc = tid % 48; float s = 0.f;
#pragma unroll
            for (int g = 0; g < 10; ++g) s += red[(g * 9 + q) * 48 + cc];
            mods[((size_t)layer * 9 + q) * 3072 + n0 + cc] = s + ada_b[layer * 3072 + n0 + cc]; }
        __syncthreads();
    }
    if (blockIdx.x == gridDim.x - 1) { float* tab = (float*)(ws + WS_TAB);
        for (int i = tid; i < 1024; i += 512) { const int pos = i >> 4, m = i & 15; const float inv = __builtin_amdgcn_exp2f(-(float)m * (13.287712379549449f / 16.f)); const float ang = (float)pos * inv;
            tab[2 * i] = __cosf(ang); tab[2 * i + 1] = __sinf(ang); } }
}
__device__ __forceinline__ void row_info(int r, int& b, int& i) { b = r / TPB; i = r - b * TPB; }
__device__ __forceinline__ void pre_rows(const float* lat, const float* ctx, const float* mods_l, const float* npre, bf16_t* H, int r0, int r1, int gw, int NGW, int lane) {
    for (int r = r0 + gw; r < r1; r += NGW) { int b, i; row_info(r, b, i);
        const float* xr = i < CTXL ? ctx + (size_t)(b * CTXL + i) * DM : lat + (size_t)(b * LAT + i - CTXL) * DM;
        const float* mod = mods_l + (size_t)(i < CTXL ? 8 : b) * 3072;
        f32x4 v[4]; float ss = 0.f;
#pragma unroll
        for (int q = 0; q < 4; ++q) { v[q] = *(const f32x4*)(xr + 4 * lane + 256 * q); ss += (v[q].x * v[q].x + v[q].y * v[q].y) + (v[q].z * v[q].z + v[q].w * v[q].w); }
        const float rstd = __builtin_amdgcn_rsqf(wave_sum(ss, lane) * (1.f / DM) + EPS);
        bf16_t* hr = H + (size_t)(r - r0) * DM;
#pragma unroll
        for (int q = 0; q < 4; ++q) { const int cc = 4 * lane + 256 * q; const f32x4 g = *(const f32x4*)(npre + cc), sh = *(const f32x4*)(mod + cc), sc = *(const f32x4*)(mod + 1024 + cc);
            const f32x4 h = v[q] * rstd * g * (sc + 1.f) + sh; u32x2 w; w.x = cvt_pk_bf16(h.x, h.y); w.y = cvt_pk_bf16(h.z, h.w); *(u32x2*)(hr + cc) = w; } }
}
__device__ __forceinline__ void post_rows(const float* slat, const float* sctx, float* dlat, float* dctx, const float* Y, const float* mods_l, const float* npost, int r0, int r1, bool write_ctx, int gw, int NGW, int lane) {
    for (int r = r0 + gw; r < r1; r += NGW) { int b, i; row_info(r, b, i);
        if (i < CTXL && !write_ctx) continue;
        const size_t off = i < CTXL ? (size_t)(b * CTXL + i) * DM : (size_t)(b * LAT + i - CTXL) * DM;
        const float* xr = (i < CTXL ? sctx : slat) + off; float* dr = (i < CTXL ? dctx : dlat) + off;
        const float* mod = mods_l + (size_t)(i < CTXL ? 8 : b) * 3072 + 2048;
        const float* yr = Y + (size_t)(r - r0) * DM;
        f32x4 v[4]; float ss = 0.f;
#pragma unroll
        for (int q = 0; q < 4; ++q) { v[q] = *(const f32x4*)(yr + 4 * lane + 256 * q); ss += (v[q].x * v[q].x + v[q].y * v[q].y) + (v[q].z * v[q].z + v[q].w * v[q].w); }
        const float rstd = __builtin_amdgcn_rsqf(wave_sum(ss, lane) * (1.f / DM) + EPS);
#pragma unroll
        for (int q = 0; q < 4; ++q) { const int cc = 4 * lane + 256 * q; const f32x4 g = *(const f32x4*)(npost + cc), gt = *(const f32x4*)(mod + cc), xv = *(const f32x4*)(xr + cc);
            *(f32x4*)(dr + cc) = xv + gt * (v[q] * rstd * g); } }
}
__device__ __forceinline__ void postpre_rows(const float* slat, const float* sctx, float* dlat, float* dctx, const bf16_t* Y, const float* mods_post, const float* npost, int a0, int a1, bool write_ctx,
                                             const float* plat, const float* pctx, const float* mods_pre, const float* npre, bf16_t* H, int b0, int b1, int gw, int NGW, int lane) {
    const int lo = a0 < b0 ? a0 : b0, hi = a1 > b1 ? a1 : b1;
    for (int r = lo + gw; r < hi; r += 4 * NGW) {
        f32x4 x[4][4], v[4][4]; size_t off[4]; int cond[4]; bool inpost[4], inpre[4], isc[4], val[4]; int rr[4];
#pragma unroll
        for (int u = 0; u < 4; ++u) { const int rq = r + u * NGW; val[u] = rq < hi; rr[u] = val[u] ? rq : r; int b, i; row_info(rr[u], b, i);
            inpost[u] = rr[u] >= a0 && rr[u] < a1; inpre[u] = rr[u] >= b0 && rr[u] < b1; isc[u] = i < CTXL; cond[u] = isc[u] ? 8 : b;
            off[u] = isc[u] ? (size_t)(b * CTXL + i) * DM : (size_t)(b * LAT + i - CTXL) * DM;
            const float* xr = inpost[u] ? ((isc[u] ? sctx : slat) + off[u]) : ((isc[u] ? pctx : plat) + off[u]);
            const bf16_t* yr = Y + (inpost[u] ? (size_t)(rr[u] - a0) * DM : (size_t)0);
#pragma unroll
            for (int q = 0; q < 4; ++q) { x[u][q] = *(const f32x4*)(xr + 4 * lane + 256 * q); const u32x2 yw = *(const u32x2*)(yr + 4 * lane + 256 * q); v[u][q] = (f32x4){bflo(yw.x), bfhi(yw.x), bflo(yw.y), bfhi(yw.y)}; } }
#pragma unroll
        for (int u = 0; u < 4; ++u) {
            if (!val[u] || (!inpost[u] && !inpre[u])) continue;
            if (inpost[u]) {
                const float* mod = mods_post + (size_t)cond[u] * 3072 + 2048; float ss = 0.f;
#pragma unroll
                for (int q = 0; q < 4; ++q) ss += (v[u][q].x * v[u][q].x + v[u][q].y * v[u][q].y) + (v[u][q].z * v[u][q].z + v[u][q].w * v[u][q].w);
                const float rstd = __builtin_amdgcn_rsqf(wave_sum(ss, lane) * (1.f / DM) + EPS);
                float* dr = (isc[u] ? dctx : dlat) + off[u]; const bool wr = !isc[u] || write_ctx;
#pragma unroll
                for (int q = 0; q < 4; ++q) { const int cc = 4 * lane + 256 * q; const f32x4 g = *(const f32x4*)(npost + cc), gt = *(const f32x4*)(mod + cc);
                    x[u][q] = x[u][q] + gt * (v[u][q] * rstd * g); if (wr) *(f32x4*)(dr + cc) = x[u][q]; }
            }
            if (inpre[u]) {
                const float* mod = mods_pre + (size_t)cond[u] * 3072; float ss = 0.f;
#pragma unroll
                for (int q = 0; q < 4; ++q) ss += (x[u][q].x * x[u][q].x + x[u][q].y * x[u][q].y) + (x[u][q].z * x[u][q].z + x[u][q].w * x[u][q].w);
                const float rstd = __builtin_amdgcn_rsqf(wave_sum(ss, lane) * (1.f / DM) + EPS);
                bf16_t* hr = H + (size_t)(rr[u] - b0) * DM;
#pragma unroll
                for (int q = 0; q < 4; ++q) { const int cc = 4 * lane + 256 * q; const f32x4 g = *(const f32x4*)(npre + cc), sh = *(const f32x4*)(mod + cc), sc = *(const f32x4*)(mod + 1024 + cc);
                    const f32x4 h = x[u][q] * rstd * g * (sc + 1.f) + sh; u32x2 w; w.x = cvt_pk_bf16(h.x, h.y); w.y = cvt_pk_bf16(h.z, h.w); *(u32x2*)(hr + cc) = w; }
            }
        }
    }
}
__device__ __forceinline__ void hg_gate_rows(const bf16_t* OF, const bf16_t* OB, const bf16_t* Z, const float* ogain, bf16_t* G, int gw, int NGW, int lane) {
    const int gc = (lane & 15) * 8;
    const f32x4 g0 = *(const f32x4*)(ogain + gc), g1 = *(const f32x4*)(ogain + gc + 4);
    const float gg[8] = {g0.x, g0.y, g0.z, g0.w, g1.x, g1.y, g1.z, g1.w};
    for (int r = gw; r < TH; r += 2 * NGW) {
        u32x4 a[2][4], b[2][4], z[2][4]; bool val[2]; size_t ro[2];
#pragma unroll
        for (int u = 0; u < 2; ++u) { const int rq = r + u * NGW; val[u] = rq < TH; ro[u] = (size_t)(val[u] ? rq : r) * DI;
#pragma unroll
            for (int it = 0; it < 4; ++it) { const size_t off = ro[u] + (it * 64 + lane) * 8; a[u][it] = __builtin_nontemporal_load((const u32x4*)(OF + off)); b[u][it] = __builtin_nontemporal_load((const u32x4*)(OB + off)); z[u][it] = __builtin_nontemporal_load((const u32x4*)(Z + off)); } }
#pragma unroll
        for (int u = 0; u < 2; ++u) { if (!val[u]) continue;
#pragma unroll
            for (int it = 0; it < 4; ++it) { const size_t off = ro[u] + (it * 64 + lane) * 8; const u32x4 aa = a[u][it], bb = b[u][it], zz4 = z[u][it];
                float o[8]; o[0] = bflo(aa.x) + bflo(bb.x); o[1] = bfhi(aa.x) + bfhi(bb.x); o[2] = bflo(aa.y) + bflo(bb.y); o[3] = bfhi(aa.y) + bfhi(bb.y);
                o[4] = bflo(aa.z) + bflo(bb.z); o[5] = bfhi(aa.z) + bfhi(bb.z); o[6] = bflo(aa.w) + bflo(bb.w); o[7] = bfhi(aa.w) + bfhi(bb.w);
                float ss = 0.f;
#pragma unroll
                for (int e = 0; e < 8; ++e) ss += o[e] * o[e];
                ss += shx(ss, 1, lane); ss += shx(ss, 2, lane); ss += shx(ss, 4, lane); ss += shx(ss, 8, lane);
                const float rstd = __builtin_amdgcn_rsqf(ss * (1.f / 128.f) + EPS);
                const float zz[8] = {bflo(zz4.x), bfhi(zz4.x), bflo(zz4.y), bfhi(zz4.y), bflo(zz4.z), bfhi(zz4.z), bflo(zz4.w), bfhi(zz4.w)};
                float y[8];
#pragma unroll
                for (int e = 0; e < 8; ++e) y[e] = o[e] * rstd * gg[e] * silu_f(zz[e]);
                u32x4 w; w.x = cvt_pk_bf16(y[0], y[1]); w.y = cvt_pk_bf16(y[2], y[3]); w.z = cvt_pk_bf16(y[4], y[5]); w.w = cvt_pk_bf16(y[6], y[7]);
                *(u32x4*)(G + off) = w; } }
    }
}
__device__ __forceinline__ void mla_norm_rows(const bf16_t* SM, const float* qag, const float* kvg, const float* tab, bf16_t* QN, bf16_t* KC, int gw, int NGW, int lane) {
    for (int r4 = gw; r4 < T; r4 += 4 * NGW) { u32x4 a4[4];
#pragma unroll
      for (int u = 0; u < 4; ++u) { const int rq = r4 + u * NGW; a4[u] = *(const u32x4*)(SM + (size_t)(rq < T ? rq : r4) * 512 + lane * 8); }
#pragma unroll
      for (int u = 0; u < 4; ++u) { const int r = r4 + u * NGW; if (r >= T) continue; int b, i; row_info(r, b, i);
        const u32x4 a = a4[u];
        float v[8] = {bflo(a.x), bfhi(a.x), bflo(a.y), bfhi(a.y), bflo(a.z), bfhi(a.z), bflo(a.w), bfhi(a.w)};
        float ss = 0.f;
#pragma unroll
        for (int e = 0; e < 8; ++e) ss += v[e] * v[e];
        const float sq = wave_sum(lane < 32 ? ss : 0.f, lane), skv = wave_sum((lane >= 32 && lane < 48) ? ss : 0.f, lane);
        float px[8];
#pragma unroll
        for (int e = 0; e < 8; ++e) px[e] = shx(v[e], 4, lane);
        if (lane < 32) { const float rstd = __builtin_amdgcn_rsqf(sq * (1.f / 256.f) + EPS); const f32x4 g0 = *(const f32x4*)(qag + lane * 8), g1 = *(const f32x4*)(qag + lane * 8 + 4);
            u32x4 w; w.x = cvt_pk_bf16(v[0] * rstd * g0.x, v[1] * rstd * g0.y); w.y = cvt_pk_bf16(v[2] * rstd * g0.z, v[3] * rstd * g0.w);
            w.z = cvt_pk_bf16(v[4] * rstd * g1.x, v[5] * rstd * g1.y); w.w = cvt_pk_bf16(v[6] * rstd * g1.z, v[7] * rstd * g1.w);
            *(u32x4*)(QN + (size_t)r * 256 + lane * 8) = w; }
        else if (lane < 48) { const int c0 = (lane - 32) * 8; const float rstd = __builtin_amdgcn_rsqf(skv * (1.f / 128.f) + EPS); const f32x4 g0 = *(const f32x4*)(kvg + c0), g1 = *(const f32x4*)(kvg + c0 + 4);
            u32x4 w; w.x = cvt_pk_bf16(v[0] * rstd * g0.x, v[1] * rstd * g0.y); w.y = cvt_pk_bf16(v[2] * rstd * g0.z, v[3] * rstd * g0.w);
            w.z = cvt_pk_bf16(v[4] * rstd * g1.x, v[5] * rstd * g1.y); w.w = cvt_pk_bf16(v[6] * rstd * g1.z, v[7] * rstd * g1.w);
            *(u32x4*)(KC + (size_t)r * 192 + c0) = w; }
        else if (lane < 52) { const int j0 = (lane - 48) * 8;
            float o[16];
#pragma unroll
            for (int e = 0; e < 8; ++e) { const int j = j0 + e; float cs = 1.f, sn = 0.f;
                if (i >= CTXL) { const int t = i - CTXL; const int pos = j < 16 ? (t >> 6) : (t & 63); const int m = j & 15; cs = tab[(pos * 16 + m) * 2]; sn = tab[(pos * 16 + m) * 2 + 1]; }
                o[2 * e] = v[e] * cs - px[e] * sn; o[2 * e + 1] = v[e] * sn + px[e] * cs; }
            u32x4 w0, w1; w0.x = cvt_pk_bf16(o[0], o[1]); w0.y = cvt_pk_bf16(o[2], o[3]); w0.z = cvt_pk_bf16(o[4], o[5]); w0.w = cvt_pk_bf16(o[6], o[7]);
            w1.x = cvt_pk_bf16(o[8], o[9]); w1.y = cvt_pk_bf16(o[10], o[11]); w1.z = cvt_pk_bf16(o[12], o[13]); w1.w = cvt_pk_bf16(o[14], o[15]);
            bf16_t* kp = KC + (size_t)r * 192 + 128 + 2 * j0; *(u32x4*)kp = w0; *(u32x4*)(kp + 8) = w1; }
    } }
}

namespace scan {
constexpr int PQ = 136, PS = 40;
constexpr int O_QI = 0, O_QA = 8704, O_KA = 17408, O_KST = 26112, O_VT = 36352, O_P = 41472, O_ST0 = 44032, O_ST1 = 61440, O_BQ = 78848  , O_DEC = 82944;
__device__ __forceinline__ int tok(int p, int j, int dir) { if (dir == 0) return 32 * p + j; const int cc = p < 8 ? 7 - p : 143 - p; return 32 * cc + 31 - j; }
__device__ __forceinline__ void scan_phase(LAS unsigned char* lds, const bf16_t* QH, const bf16_t* VH, const _Float16* GFB  , bf16_t* OFB  , const float* lbl  , int jl, int& tidv) {
    const int tid = opaque_tid(tidv), w = __builtin_amdgcn_readfirstlane(tid >> 6), lane = tid & 63, fr = lane & 15, fq = lane >> 4;
    const int kp = tid & 63, tg = tid >> 6;
    const int vs = tid >> 4, vd = (tid & 15) * 4;
    LAS bf16_t* QI = (LAS bf16_t*)(lds + O_QI); LAS bf16_t* QA = (LAS bf16_t*)(lds + O_QA); LAS bf16_t* KA = (LAS bf16_t*)(lds + O_KA);
    LAS bf16_t* KST = (LAS bf16_t*)(lds + O_KST); LAS bf16_t* VT = (LAS bf16_t*)(lds + O_VT); LAS bf16_t* Pm = (LAS bf16_t*)(lds + O_P);
    LAS float* BQ = (LAS float*)(lds + O_BQ); LAS float* DEC = (LAS float*)(lds + O_DEC);
    constexpr float L2E = 1.4426950408889634f;
    for (int item = opaque_bid(); item < 256; item += gridDim.x) {
        const int dvh = item & 1, dir = (item >> 1) & 1, h = (item >> 2) & 15, bl = item >> 6;
        float lb0 = 0.f, lb1 = 0.f;
        if (jl == 1) { const f32x2 l0 = *(const f32x2*)(lbl + dir * DI + h * 128 + 2 * kp), l1 = *(const f32x2*)(lbl + 2 * DI + dir * DI + h * 128 + 2 * kp);
            lb0 = 1.f / (1.f + __expf(l0.x - l1.x)); lb1 = 1.f / (1.f + __expf(l0.y - l1.y)); }
        const float om0 = 1.f - lb0, om1 = 1.f - lb1;
        const size_t rowbase = (size_t)bl * TPB;
        const _Float16* Gp = GFB + (size_t)dir * ((size_t)TH * DI) + h * 128 + 2 * kp;
        const bf16_t* Qp = QH + h * 128 + 2 * kp;
        const bf16_t* Vp = VH + h * 128 + dvh * 64 + vd;
        bf16_t* Op = OFB + (size_t)dir * ((size_t)TH * DI) + h * 128 + dvh * 64;
        f32x4 S[4];
#pragma unroll
        for (int tv = 0; tv < 4; ++tv) S[tv] = (f32x4){0.f, 0.f, 0.f, 0.f};
        for (int i = tid; i < 17408 / 4; i += 512) ((LAS unsigned*)(lds + O_ST0))[i] = 0u;
        unsigned ggA[4], gqA[4], ggB[4], gqB[4]; u32x2 vrawA, vrawB;
#define SC_LOAD(pp, gg, gq, vraw) do { _Pragma("unroll") for (int j = 0; j < 4; ++j) { const size_t ro = (rowbase + tok((pp), 4 * tg + j, dir)) * DI; gg[j] = *(const unsigned*)(Gp + ro); gq[j] = *(const unsigned*)(Qp + ro); } \
        vraw = *(const u32x2*)(Vp + (rowbase + tok((pp), vs, dir)) * DI); } while (0)
        SC_LOAD(0, ggA, gqA, vrawA); SC_LOAD(1, ggB, gqB, vrawB);
        __syncthreads();
#define SC_STEP(p, gg, gq, vraw) do { \
            LAS bf16_t* STc = (LAS bf16_t*)(lds + ((p & 1) ? O_ST1 : O_ST0)); LAS bf16_t* STn = (LAS bf16_t*)(lds + ((p & 1) ? O_ST0 : O_ST1)); \
            float kk0[4], kk1[4], cu0[4], cu1[4]; float c0 = 0.f, c1 = 0.f; \
_Pragma("unroll") \
            for (int j = 0; j < 4; ++j) { const h16x2 gh = __builtin_bit_cast(h16x2, gg[j]); \
                const float g0 = fminf(fmaxf((float)gh.x, -30.f), 30.f), g1 = fminf(fmaxf((float)gh.y, -30.f), 30.f); \
                const float s0 = __builtin_amdgcn_rcpf(1.f + __builtin_amdgcn_exp2f(-L2E * g0)), s1 = __builtin_amdgcn_rcpf(1.f + __builtin_amdgcn_exp2f(-L2E * g1)); \
                c0 += __builtin_amdgcn_logf(lb0 + om0 * s0); c1 += __builtin_amdgcn_logf(lb1 + om1 * s1); cu0[j] = c0; cu1[j] = c1; \
                kk0[j] = om0 - om0 * s0; kk1[j] = om1 - om1 * s1; } \
            *(LAS f32x2*)(BQ + tg * 128 + 2 * kp) = (f32x2){c0, c1}; \
            __syncthreads(); \
            { float pre0 = 0.f, pre1 = 0.f, mid0 = 0.f, mid1 = 0.f, tot0 = 0.f, tot1 = 0.f; \
_Pragma("unroll") \
              for (int g = 0; g < 8; ++g) { const f32x2 v = *(const LAS f32x2*)(BQ + g * 128 + 2 * kp); \
                  if (g < tg) { pre0 += v.x; pre1 += v.y; } if (g < 4) { mid0 += v.x; mid1 += v.y; } tot0 += v.x; tot1 += v.y; } \
              const float em0 = __builtin_amdgcn_exp2f(mid0), em1 = __builtin_amdgcn_exp2f(mid1), el0 = __builtin_amdgcn_exp2f(tot0 - mid0), el1 = __builtin_amdgcn_exp2f(tot1 - mid1); \
              unsigned ks0[2], ks1[2]; \
_Pragma("unroll") \
              for (int j = 0; j < 4; ++j) { const int t = 4 * tg + j; \
                  const float x0 = fminf(fmaxf(pre0 + cu0[j] - mid0, -115.f), 115.f), x1 = fminf(fmaxf(pre1 + cu1[j] - mid1, -115.f), 115.f); \
                  const float a0 = __builtin_amdgcn_exp2f(x0), a1 = __builtin_amdgcn_exp2f(x1), r0 = __builtin_amdgcn_rcpf(a0), r1 = __builtin_amdgcn_rcpf(a1); \
                  const float qa0 = bflo(gq[j]) * a0, qa1 = bfhi(gq[j]) * a1, ka0 = kk0[j] * r0, ka1 = kk1[j] * r1; \
                  *(LAS unsigned*)(QA + t * PQ + 2 * kp) = cvt_pk_bf16(qa0, qa1); \
                  *(LAS unsigned*)(QI + t * PQ + 2 * kp) = cvt_pk_bf16(qa0 * em0, qa1 * em1); \
                  *(LAS unsigned*)(KA + t * PQ + 2 * kp) = cvt_pk_bf16(ka0, ka1); \
                  const unsigned kz = cvt_pk_bf16(ka0 * el0, ka1 * el1);       \
                  if (j & 1) { ks0[j >> 1] |= kz << 16; ks1[j >> 1] |= kz & 0xffff0000u; } else { ks0[j >> 1] = kz & 0xffffu; ks1[j >> 1] = kz >> 16; } } \
              *(LAS u32x2*)(KST + (2 * kp) * PS + 4 * tg) = (u32x2){ks0[0], ks0[1]}; \
              *(LAS u32x2*)(KST + (2 * kp + 1) * PS + 4 * tg) = (u32x2){ks1[0], ks1[1]}; \
              if (tg == 0) *(LAS f32x2*)(DEC + 2 * kp) = (f32x2){__builtin_amdgcn_exp2f(tot0), __builtin_amdgcn_exp2f(tot1)}; \
              VT[(vd + 0) * PS + vs] = (bf16_t)(vraw.x & 0xffffu); VT[(vd + 1) * PS + vs] = (bf16_t)(vraw.x >> 16); \
              VT[(vd + 2) * PS + vs] = (bf16_t)(vraw.y & 0xffffu); VT[(vd + 3) * PS + vs] = (bf16_t)(vraw.y >> 16); } \
            __syncthreads(); \
            if (p + 2 < 136) SC_LOAD(p + 2, gg, gq, vraw); \
            if (w < 4) {    \
                const int tm = w >> 1, tn = w & 1; f32x4 sc = (f32x4){0.f, 0.f, 0.f, 0.f}; \
_Pragma("unroll") \
                for (int ks = 0; ks < 4; ++ks) { const bf16x8 X = *(const LAS bf16x8*)(QA + (16 * tm + fr) * PQ + 32 * ks + 8 * fq), Y = *(const LAS bf16x8*)(KA + (16 * tn + fr) * PQ + 32 * ks + 8 * fq); \
                    sc = __builtin_amdgcn_mfma_f32_16x16x32_bf16(X, Y, sc, 0, 0, 0); } \
                const int s = 16 * tn + fr; \
_Pragma("unroll") \
                for (int e = 0; e < 4; ++e) { const int t = 16 * tm + 4 * fq + e; Pm[t * PS + s] = (bf16_t)((s <= t) ? f2bf(sc[e]) : 0u); } \
            } \
            const int tm = w >> 2, tn = w & 3; f32x4 oa = (f32x4){0.f, 0.f, 0.f, 0.f}; \
_Pragma("unroll") \
            for (int ks = 0; ks < 4; ++ks) { const bf16x8 X = *(const LAS bf16x8*)(QI + (16 * tm + fr) * PQ + 32 * ks + 8 * fq), Y = *(const LAS bf16x8*)(STc + (16 * tn + fr) * PQ + 32 * ks + 8 * fq); \
                oa = __builtin_amdgcn_mfma_f32_16x16x32_bf16(X, Y, oa, 0, 0, 0); } \
            { const bf16x8 X = *(const LAS bf16x8*)(KST + (16 * w + fr) * PS + 8 * fq); const f32x4 dec = *(const LAS f32x4*)(DEC + 16 * w + 4 * fq); \
_Pragma("unroll") \
              for (int tv = 0; tv < 4; ++tv) { const bf16x8 Y = *(const LAS bf16x8*)(VT + (16 * tv + fr) * PS + 8 * fq); \
                  S[tv] = __builtin_amdgcn_mfma_f32_16x16x32_bf16(X, Y, S[tv] * dec, 0, 0, 0); \
                  u32x2 sw; sw.x = cvt_pk_bf16(S[tv][0], S[tv][1]); sw.y = cvt_pk_bf16(S[tv][2], S[tv][3]); \
                  *(LAS u32x2*)(STn + (16 * tv + fr) * PQ + 16 * w + 4 * fq) = sw; } } \
            __syncthreads(); \
            { const bf16x8 X = *(const LAS bf16x8*)(Pm + (16 * tm + fr) * PS + 8 * fq), Y = *(const LAS bf16x8*)(VT + (16 * tn + fr) * PS + 8 * fq); \
              oa = __builtin_amdgcn_mfma_f32_16x16x32_bf16(X, Y, oa, 0, 0, 0); } \
_Pragma("unroll") \
            for (int e = 0; e < 4; ++e) { const int t = 16 * tm + 4 * fq + e; Op[(rowbase + tok(p, t, dir)) * DI + 16 * tn + fr] = (bf16_t)f2bf(oa[e]); } \
        } while (0)
        for (int p2 = 0; p2 < 136; p2 += 2) { SC_STEP(p2, ggA, gqA, vrawA); SC_STEP(p2 + 1, ggB, gqB, vrawB); }
        __syncthreads();
#undef SC_LOAD
#undef SC_STEP
    }
}
}


typedef const __attribute__((address_space(4))) Params* KParams;
__device__ __forceinline__ KParams kp_get() { KParams q = (KParams)__builtin_amdgcn_kernarg_segment_ptr(); asm volatile("" : "+s"(q)); return q; }
namespace scan2 {
constexpr int PQ = 136, PS = 40;
constexpr int BUF = 41984, B_QI = 0, B_QA = 8704, B_KA = 17408, B_KST = 26112, B_VT = 36352, B_DEC = 41472;
constexpr int O_P = 2 * BUF, O_ST0 = O_P + 2560, O_ST1 = O_ST0 + 17408, O_BQ = O_ST1 + 17408;
__device__ __forceinline__ int tok(int p, int j, int dir) { if (dir == 0) return 32 * p + j; const int cc = p < 8 ? 7 - p : 143 - p; return 32 * cc + 31 - j; }
#define QI ((LAS bf16_t*)(bufp + B_QI))
#define QA ((LAS bf16_t*)(bufp + B_QA))
#define KA ((LAS bf16_t*)(bufp + B_KA))
#define KST ((LAS bf16_t*)(bufp + B_KST))
#define VT ((LAS bf16_t*)(bufp + B_VT))
#define DEC ((LAS float*)(bufp + B_DEC))
#ifndef PROBE_ID
#define PROBE_ID 0
#endif
#define SCT0(id, cond) do { if (PROBE_ID == (id) && blockIdx.x == 0 && (cond) && lane == 0) sct_ = __builtin_amdgcn_s_memrealtime(); } while (0)
#define SCT1(id, cond) do { if (PROBE_ID == (id) && blockIdx.x == 0 && (cond) && lane == 0) { volatile LAS unsigned long long* q_ = (volatile LAS unsigned long long*)(lds + 147456 - 32); q_[1] = q_[1] + (__builtin_amdgcn_s_memrealtime() - sct_); } } while (0)
#define SC2_BAR() do { asm volatile("s_waitcnt lgkmcnt(0)" ::: "memory"); __builtin_amdgcn_s_barrier(); asm volatile("" ::: "memory"); } while (0)
__device__ __forceinline__ void scan_phase(LAS unsigned char* lds, int jl, int& tidv) {
    const int tid = opaque_tid(tidv), w = __builtin_amdgcn_readfirstlane(tid >> 6), lane = tid & 63, fr = lane & 15, fq = lane >> 4;
    constexpr float L2E = 1.4426950408889634f; unsigned long long sct_ = 0ull; (void)sct_;
    LAS bf16_t* Pm = (LAS bf16_t*)(lds + O_P); LAS float* BQ = (LAS float*)(lds + O_BQ);
    { const int bid_ = opaque_bid() & 255;
      const int item = ((((bid_ >> 3) >> 2) * 8 + (bid_ & 7)) << 2) | ((bid_ >> 3) & 3);
        const int dvh = item & 1, dir = (item >> 1) & 1, h = (item >> 2) & 15, bl = item >> 6;
        const KParams kq_ = kp_get(); unsigned char* ws_ = kq_->ws; const bf16_t* QH = (const bf16_t*)(ws_ + WS_HG_P); const bf16_t* VH = QH + (size_t)TH * DI; const _Float16* GFB = (const _Float16*)(QH + 2 * (size_t)TH * DI);
        bf16_t* OFB = (bf16_t*)(ws_ + WS_HG_OF); const float* lbl = kq_->hg_lb;
        const unsigned rowbase = (unsigned)bl * TPB;
        for (int i = tid; i < 17408 / 4; i += 512) ((LAS unsigned*)(lds + O_ST0))[i] = 0u;
        SC2_BAR();
        if (w < 4) {
            const int kp = tid & 63, tg = w;
            float lb0 = 0.f, lb1 = 0.f;
            if (jl == 1) { const f32x2 l0 = *(const f32x2*)(lbl + dir * DI + h * 128 + 2 * kp), l1 = *(const f32x2*)(lbl + 2 * DI + dir * DI + h * 128 + 2 * kp);
                lb0 = 1.f / (1.f + __expf(l0.x - l1.x)); lb1 = 1.f / (1.f + __expf(l0.y - l1.y)); }
            const float om0 = 1.f - lb0, om1 = 1.f - lb1;
            const char* Gb = (const char*)(GFB + (size_t)dir * ((size_t)TH * DI) + h * 128); const char* Qb = (const char*)(QH + h * 128); const unsigned lo4 = (unsigned)kp * 4u;
            unsigned ggA[8], gqA[8], ggB[8], gqB[8];
#define SC2_LOAD_GV(pp, gg, vr) do { _Pragma("unroll") for (int j = 0; j < 8; ++j) { const unsigned rb = (rowbase + (unsigned)tok((pp), 8 * tg + j, dir)) * (DI * 2); gg[j] = *(const unsigned*)(Gb + rb + lo4); } } while (0)
#define SC2_LOAD_Q(pp, gq) do { _Pragma("unroll") for (int j = 0; j < 8; ++j) { const unsigned rb = (rowbase + (unsigned)tok((pp), 8 * tg + j, dir)) * (DI * 2); gq[j] = *(const unsigned*)(Qb + rb + lo4); } } while (0)
#define SC2_LOAD(pp, gg, gq, vr) do { SC2_LOAD_GV(pp, gg, vr); SC2_LOAD_Q(pp, gq); } while (0)
#define SC2_PREP(n, gg, gq, vr) do { \
            LAS unsigned char* bufp = lds + ((n) & 1) * BUF; \
            SCT0(21, w == 0); \
            float kk0[8], kk1[8], av0[8], av1[8], rv0[8], rv1[8], f0_[8], f1_[8], q0_[8], q1_[8]; \
            _Pragma("unroll") for (int j = 0; j < 8; ++j) { const h16x2 gh = __builtin_bit_cast(h16x2, gg[j]); \
                const float g0 = fmaxf((float)gh.x, -13.8f), g1 = fmaxf((float)gh.y, -13.8f); \
                const float u0 = 1.f + __builtin_amdgcn_exp2f(-L2E * g0), u1 = 1.f + __builtin_amdgcn_exp2f(-L2E * g1); \
                const float s0 = __builtin_amdgcn_rcpf(u0), s1 = __builtin_amdgcn_rcpf(u1); \
                f0_[j] = lb0 + om0 * s0; f1_[j] = lb1 + om1 * s1; q0_[j] = (jl == 0) ? u0 : __builtin_amdgcn_rcpf(f0_[j]); q1_[j] = (jl == 0) ? u1 : __builtin_amdgcn_rcpf(f1_[j]); \
                kk0[j] = 1.f - f0_[j]; kk1[j] = 1.f - f1_[j]; } \
            { float pf0 = 1.f, pf1 = 1.f, pr0 = 1.f, pr1 = 1.f; \
              if (tg >= 2) { _Pragma("unroll") for (int j = 0; j < 8; ++j) { pf0 *= f0_[j]; pf1 *= f1_[j]; pr0 *= q0_[j]; pr1 *= q1_[j]; av0[j] = pf0; av1[j] = pf1; rv0[j] = pr0; rv1[j] = pr1; } } \
              else { _Pragma("unroll") for (int j = 7; j >= 0; --j) { av0[j] = pr0; av1[j] = pr1; rv0[j] = pf0; rv1[j] = pf1; pf0 *= f0_[j]; pf1 *= f1_[j]; pr0 *= q0_[j]; pr1 *= q1_[j]; } } \
              *(LAS f32x4*)(BQ + (tg * 64 + kp) * 4) = (f32x4){pf0, pf1, pr0, pr1}; } \
            float qf0[8], qf1[8]; _Pragma("unroll") for (int j = 0; j < 8; ++j) { qf0[j] = bflo(gq[j]); qf1[j] = bfhi(gq[j]); } \
            if ((n) + 2 < 136) { SC2_LOAD_GV((n) + 2, gg, vr); SC2_LOAD_Q((n) + 2, gq); } \
            if (PROBE_ID == 21) asm volatile("s_waitcnt lgkmcnt(0)" ::: "memory"); SCT1(21, w == 0); \
            SC2_BAR(); SCT0(22, w == 0); \
            { const f32x4 b0 = *(const LAS f32x4*)(BQ + (0 * 64 + kp) * 4), b1 = *(const LAS f32x4*)(BQ + (1 * 64 + kp) * 4), b2 = *(const LAS f32x4*)(BQ + (2 * 64 + kp) * 4), b3 = *(const LAS f32x4*)(BQ + (3 * 64 + kp) * 4); \
              const float em0 = b0[0] * b1[0], em1 = b0[1] * b1[1], el0 = b2[0] * b3[0], el1 = b2[1] * b3[1]; \
              float ca0 = 1.f, ca1 = 1.f, cr0 = 1.f, cr1 = 1.f; \
              if (tg == 0) { ca0 = b1[2]; ca1 = b1[3]; cr0 = b1[0]; cr1 = b1[1]; } else if (tg == 3) { ca0 = b2[0]; ca1 = b2[1]; cr0 = b2[2]; cr1 = b2[3]; } \
              unsigned ks0[4], ks1[4]; \
              _Pragma("unroll") for (int j = 0; j < 8; ++j) { const int t = 8 * tg + j; \
                  const float a0 = __builtin_amdgcn_fmed3f(av0[j] * ca0, 1e-30f, 1e30f), a1 = __builtin_amdgcn_fmed3f(av1[j] * ca1, 1e-30f, 1e30f); \
                  const float r0 = __builtin_amdgcn_fmed3f(rv0[j] * cr0, 1e-30f, 1e30f), r1 = __builtin_amdgcn_fmed3f(rv1[j] * cr1, 1e-30f, 1e30f); \
                  const float qa0 = qf0[j] * a0, qa1 = qf1[j] * a1, ka0 = kk0[j] * r0, ka1 = kk1[j] * r1; \
                  *(LAS unsigned*)(QA + t * PQ + 2 * kp) = cvt_pk_bf16(qa0, qa1); \
                  *(LAS unsigned*)(QI + t * PQ + 2 * kp) = cvt_pk_bf16(qa0 * em0, qa1 * em1); \
                  *(LAS unsigned*)(KA + t * PQ + 2 * kp) = cvt_pk_bf16(ka0, ka1); \
                  const unsigned kz = cvt_pk_bf16(ka0 * el0, ka1 * el1); \
                  if (j & 1) { ks0[j >> 1] |= kz << 16; ks1[j >> 1] |= kz & 0xffff0000u; } else { ks0[j >> 1] = kz & 0xffffu; ks1[j >> 1] = kz >> 16; } } \
              *(LAS u32x4*)(KST + (2 * kp) * PS + 8 * tg) = (u32x4){ks0[0], ks0[1], ks0[2], ks0[3]}; \
              *(LAS u32x4*)(KST + (2 * kp + 1) * PS + 8 * tg) = (u32x4){ks1[0], ks1[1], ks1[2], ks1[3]}; \
              if (tg == 0) *(LAS f32x2*)(DEC + 2 * kp) = (f32x2){em0 * el0, em1 * el1}; \
              } \
            if (PROBE_ID == 22) asm volatile("s_waitcnt lgkmcnt(0)" ::: "memory"); SCT1(22, w == 0); \
            SC2_BAR(); \
        } while (0)
            SC2_LOAD(0, ggA, gqA, 0); SC2_LOAD(1, ggB, gqB, 0);
            for (int n2 = 0; n2 < 136; n2 += 2) { SC2_PREP(n2, ggA, gqA, 0); SC2_PREP(n2 + 1, ggB, gqB, 0); }
            SC2_BAR(); SC2_BAR();
#undef SC2_LOAD
#undef SC2_LOAD_GV
#undef SC2_LOAD_Q
#undef SC2_PREP
        } else {
            const int wm = w - 4;
            const int vs = tid & 31, vd = ((tid >> 5) & 7) * 8;
            const bf16_t* Vp = VH + h * 128 + dvh * 64 + vd;
            u32x4 vr = *(const u32x4*)(Vp + (rowbase + (unsigned)tok(0, vs, dir)) * DI);
#define SC2_VT(nn) do { LAS bf16_t* vt_ = (LAS bf16_t*)(lds + ((nn) & 1) * BUF + B_VT); \
            vt_[(vd + 0) * PS + vs] = (bf16_t)(vr.x & 0xffffu); vt_[(vd + 1) * PS + vs] = (bf16_t)(vr.x >> 16); vt_[(vd + 2) * PS + vs] = (bf16_t)(vr.y & 0xffffu); vt_[(vd + 3) * PS + vs] = (bf16_t)(vr.y >> 16); \
            vt_[(vd + 4) * PS + vs] = (bf16_t)(vr.z & 0xffffu); vt_[(vd + 5) * PS + vs] = (bf16_t)(vr.z >> 16); vt_[(vd + 6) * PS + vs] = (bf16_t)(vr.w & 0xffffu); vt_[(vd + 7) * PS + vs] = (bf16_t)(vr.w >> 16); \
            if ((nn) + 1 < 136) vr = *(const u32x4*)(Vp + (rowbase + (unsigned)tok((nn) + 1, vs, dir)) * DI); } while (0)
            bf16_t* Op = OFB + (size_t)dir * ((size_t)TH * DI) + h * 128 + dvh * 64;
            f32x4 S[2][4];
#pragma unroll
            for (int kt = 0; kt < 2; ++kt)
#pragma unroll
                for (int tv = 0; tv < 4; ++tv) S[kt][tv] = (f32x4){0.f, 0.f, 0.f, 0.f};
            SC2_VT(0);
            SC2_BAR(); SC2_BAR();
            for (int n = 1; n <= 136; ++n) {
                const int p = n - 1;
                LAS unsigned char* bufp = lds + (p & 1) * BUF;
                LAS bf16_t* STc = (LAS bf16_t*)(lds + ((p & 1) ? O_ST1 : O_ST0)); LAS bf16_t* STn = (LAS bf16_t*)(lds + ((p & 1) ? O_ST0 : O_ST1));
                SCT0(23, w == 4);
                {
                    const int tm = wm >> 1, tn = wm & 1; f32x4 sc = (f32x4){0.f, 0.f, 0.f, 0.f};
#pragma unroll
                    for (int ks = 0; ks < 4; ++ks) { const bf16x8 X = *(const LAS bf16x8*)(QA + (16 * tm + fr) * PQ + 32 * ks + 8 * fq), Y = *(const LAS bf16x8*)(KA + (16 * tn + fr) * PQ + 32 * ks + 8 * fq);
                        sc = __builtin_amdgcn_mfma_f32_16x16x32_bf16(X, Y, sc, 0, 0, 0); }
                    const int s_ = 16 * tn + fr;
#pragma unroll
                    for (int e = 0; e < 4; ++e) { const int t = 16 * tm + 4 * fq + e; Pm[t * PS + s_] = (bf16_t)((s_ <= t) ? (cvt_pk_bf16(sc[e], 0.f) & 0xffffu) : 0u); }
                }
                {
                    bf16x8 Yv[4];
#pragma unroll
                    for (int tv = 0; tv < 4; ++tv) Yv[tv] = *(const LAS bf16x8*)(VT + (16 * tv + fr) * PS + 8 * fq);
#pragma unroll
                    for (int kt = 0; kt < 2; ++kt) { const int k0 = 32 * wm + 16 * kt; const bf16x8 X = *(const LAS bf16x8*)(KST + (k0 + fr) * PS + 8 * fq); const f32x4 dec = *(const LAS f32x4*)(DEC + k0 + 4 * fq);
#pragma unroll
                        for (int tv = 0; tv < 4; ++tv) { S[kt][tv] = __builtin_amdgcn_mfma_f32_16x16x32_bf16(X, Yv[tv], S[kt][tv] * dec, 0, 0, 0);
                            u32x2 sw; sw.x = cvt_pk_bf16(S[kt][tv][0], S[kt][tv][1]); sw.y = cvt_pk_bf16(S[kt][tv][2], S[kt][tv][3]);
                            *(LAS u32x2*)(STn + (16 * tv + fr) * PQ + k0 + 4 * fq) = sw; } }
                }
                if (PROBE_ID == 23) asm volatile("s_waitcnt lgkmcnt(0)" ::: "memory"); SCT1(23, w == 4);
                SC2_BAR(); SCT0(24, w == 4);
                f32x4 oa[2];
                {
                    oa[0] = (f32x4){0.f, 0.f, 0.f, 0.f}; oa[1] = oa[0];
#pragma unroll
                    for (int ks = 0; ks < 4; ++ks) { const bf16x8 Y = *(const LAS bf16x8*)(STc + (16 * wm + fr) * PQ + 32 * ks + 8 * fq);
                        const bf16x8 X0 = *(const LAS bf16x8*)(QI + fr * PQ + 32 * ks + 8 * fq), X1 = *(const LAS bf16x8*)(QI + (16 + fr) * PQ + 32 * ks + 8 * fq);
                        oa[0] = __builtin_amdgcn_mfma_f32_16x16x32_bf16(X0, Y, oa[0], 0, 0, 0); oa[1] = __builtin_amdgcn_mfma_f32_16x16x32_bf16(X1, Y, oa[1], 0, 0, 0); }
                }
                {
                    const bf16x8 Y = *(const LAS bf16x8*)(VT + (16 * wm + fr) * PS + 8 * fq);
                    const bf16x8 X0 = *(const LAS bf16x8*)(Pm + fr * PS + 8 * fq), X1 = *(const LAS bf16x8*)(Pm + (16 + fr) * PS + 8 * fq);
                    oa[0] = __builtin_amdgcn_mfma_f32_16x16x32_bf16(X0, Y, oa[0], 0, 0, 0); oa[1] = __builtin_amdgcn_mfma_f32_16x16x32_bf16(X1, Y, oa[1], 0, 0, 0);
#pragma unroll
                    for (int tm = 0; tm < 2; ++tm)
#pragma unroll
                        for (int e = 0; e < 4; ++e) { const int t = 16 * tm + 4 * fq + e; Op[(rowbase + (unsigned)tok(p, t, dir)) * DI + 16 * wm + fr] = (bf16_t)(cvt_pk_bf16(oa[tm][e], 0.f) & 0xffffu); }
                }
                if (n < 136) SC2_VT(n);
                SCT1(24, w == 4);
                SC2_BAR();
            }
        }
        SC2_BAR();
    }
}
#undef SC2_BAR
#undef SC2_VT
#undef SCT0
#undef SCT1
#undef QI
#undef QA
#undef KA
#undef KST
#undef VT
#undef DEC
}

#define XB_TMO      128
#define XB_XCNT(j)  (256  + 64 * (j))
#define XB_XSUB(j)  (1280 + 64 * (j))
#define XB_XGEN(j)  (2304 + 64 * (j))
#define XB_TOP      3328
#define XB_TOPGEN   3392
#define XCD_BAR_WORDS 3456
#define XB_SPIN_CAP (1u << 18)
__device__ __forceinline__ unsigned xb_ld(unsigned* p)              { return __hip_atomic_load(p, __ATOMIC_RELAXED, __HIP_MEMORY_SCOPE_AGENT); }
__device__ __forceinline__ unsigned xb_add(unsigned* p, unsigned v) { return __hip_atomic_fetch_add(p, v, __ATOMIC_RELAXED, __HIP_MEMORY_SCOPE_AGENT); }
__device__ __forceinline__ unsigned xb_xcc_id() { return (unsigned)__builtin_amdgcn_s_getreg((3 << 11) | 20) & 0xFu; }
#define XB_SPIN(cond, bar) do { unsigned _sp = 0; while (cond) { __builtin_amdgcn_s_sleep(1); \
    if ((++_sp & 255u) == 0u) { if (xb_ld(&(bar)[XB_TMO])) break; if (_sp > XB_SPIN_CAP) { atomicAdd(&(bar)[XB_TMO], 1u); break; } } } } while (0)
__device__ __forceinline__ void xcd_barrier_complete(unsigned* bar, unsigned x, unsigned& nloc, unsigned& nx) {
    const unsigned G = gridDim.x * gridDim.y * gridDim.z;
    unsigned sum, cnt, mine, sp = 0u;
    for (;;) {
        sum = 0u; cnt = 0u; mine = 0u;
#pragma unroll
        for (unsigned j = 0; j < 16; ++j) { const unsigned c = xb_ld(&bar[XB_XCNT(j)]); sum += c; cnt += (c > 0u) ? 1u : 0u; mine = (j == x) ? c : mine; }
        if (sum == G) break;
        __builtin_amdgcn_s_sleep(1);
        if ((++sp & 255u) == 0u) { if (xb_ld(&bar[XB_TMO])) break; if (sp > XB_SPIN_CAP) { atomicAdd(&bar[XB_TMO], 1u); break; } }
    }
    nloc = mine > 0u ? mine : 1u; nx = cnt > 0u ? cnt : 1u;
}
__device__ __forceinline__ void xcd_barrier(unsigned* bar, volatile LAS unsigned* st, bool is_t0) {
    asm volatile("s_waitcnt vmcnt(0)" ::: "memory");
    __syncthreads();
    if (is_t0) {
        const unsigned x = xb_xcc_id();
        __builtin_amdgcn_s_waitcnt(0);
        unsigned nloc = st[0], nx = st[1];
        if (nloc == 0u) { xcd_barrier_complete(bar, x, nloc, nx); st[0] = nloc; st[1] = nx; }
        const unsigned old = xb_add(&bar[XB_XSUB(x)], 1u);
        const unsigned gen = old / nloc;
        if (old + 1u == (gen + 1u) * nloc) {
            __builtin_amdgcn_fence(__ATOMIC_RELEASE, "agent");
            asm volatile("s_waitcnt vmcnt(0)" ::: "memory");
            const unsigned og = xb_add(&bar[XB_TOP], 1u);
            const unsigned tg = og / nx;
            if (og + 1u == (tg + 1u) * nx) xb_add(&bar[XB_TOPGEN], 1u);
            else XB_SPIN(xb_ld(&bar[XB_TOPGEN]) == tg, bar);
            __builtin_amdgcn_fence(__ATOMIC_ACQUIRE, "agent");
            xb_add(&bar[XB_XGEN(x)], 1u);
            asm volatile("s_waitcnt vmcnt(0)" ::: "memory");
        } else {
            XB_SPIN(xb_ld(&bar[XB_XGEN(x)]) == gen, bar);
            __builtin_amdgcn_fence(__ATOMIC_ACQUIRE, "agent");
            asm volatile("s_waitcnt vmcnt(0)" ::: "memory");
        }
    }
    __syncthreads();
}

#ifndef GEMM_MASK
#define GEMM_MASK 63
#endif
#define GEMM_CALLN(n) do { if constexpr ((GEMM_MASK >> (n)) & 1) pg8::gemm_phase(lds, g, S, E, tidv); else { (void)g; (void)S; (void)E; } } while (0)
#define KP(field) (kp_get()->field)


#define IDS const int tid = opaque_tid(tidv), lane = tid & 63, wave = __builtin_amdgcn_readfirstlane(tid >> 6); (void)tid; (void)lane; (void)wave
#ifndef PROBE_ID
#define PROBE_ID 0
#endif
#define PROBE_MATCH(id) (PROBE_ID == 100 ? ((id) == 2 || (id) == 5 || (id) == 8 || (id) == 10 || (id) == 12 || (id) == 13) : (PROBE_ID == 101 ? ((id) == 4 || (id) == 6 || (id) == 9 || (id) == 14 || (id) == 15) : PROBE_ID == (id)))
#define PT_BEGIN(id) do { if (PROBE_MATCH(id) && blockIdx.x == 0 && tidv == 0) { *(volatile LAS unsigned long long*)(lds + 147456 - 32) = __builtin_amdgcn_s_memrealtime(); } } while (0)
#define PT_END(id) do { if (PROBE_MATCH(id) && blockIdx.x == 0 && tidv == 0) { volatile LAS unsigned long long* q_ = (volatile LAS unsigned long long*)(lds + 147456 - 32); q_[1] = q_[1] + (__builtin_amdgcn_s_memrealtime() - q_[0]); } } while (0)
#define LPV lp
#define CGSYNC() do { PT_BEGIN(16); asm volatile("s_waitcnt vmcnt(0) lgkmcnt(0)" ::: "memory"); grid.sync(); __builtin_amdgcn_fence(__ATOMIC_ACQUIRE, "agent"); asm volatile("s_waitcnt vmcnt(0)" ::: "memory"); PT_END(16); } while (0)
#define GSYNC() do { PT_BEGIN(16); xcd_barrier((unsigned*)(kp_get()->ws) + 1024, (volatile LAS unsigned*)(lds + 147456 - 64), tidv == 0); PT_END(16); } while (0)
#define GW (opaque_bid() * 8 + wave)
#define NGW_ ((int)gridDim.x * 8)
template <int lp, int hf>
__device__ __forceinline__ void hgrn_pass(LAS unsigned char* lds, unsigned char* lds_raw, cg::grid_group& grid, int& tidv) { PT_BEGIN(1);

                const int r0 = hf * TH, r1 = r0 + TH;
                PT_BEGIN(2);
                { unsigned char* ws = KP(ws);
                  pg8::Gemm g{(const bf16_t*)(ws + WS_HG_H), (const bf16_t*)(ws + WS_HG_WIN), TH, 10240, DM, DM, DM, 0}; pg8::StaticOrder S; S.init(TH, 10240, (int)gridDim.x, opaque_bid());
                  pg8::EpiHgIn E{(bf16_t*)(ws + WS_HG_P)}; GEMM_CALLN(0); }
                GSYNC(); PT_END(2); PT_BEGIN(3);
#ifndef NO_SCAN
                scan2::scan_phase(lds, LPV, tidv);
#endif
                GSYNC(); PT_END(3); PT_BEGIN(4);
                { IDS; KParams k = kp_get(); unsigned char* ws = k->ws; bf16_t* OFb = (bf16_t*)(ws + WS_HG_OF);
                  hg_gate_rows(OFb, OFb + (size_t)TH * DI, (const bf16_t*)(ws + WS_HG_P) + 4 * (size_t)TH * DI, k->hg_o_norm + LPV * 128, (bf16_t*)(ws + WS_HG_GATED), GW, NGW_, lane); }
                GSYNC(); PT_END(4); PT_BEGIN(5);
                { unsigned char* ws = KP(ws);
                  pg8::Gemm g{(const bf16_t*)(ws + WS_HG_GATED), (const bf16_t*)(ws + WS_HG_WOUT), TH, DM, DI, DI, DI, 0}; pg8::StaticOrder S; S.init(TH, DM, (int)gridDim.x, opaque_bid());
                  pg8::EpiF32 E{(bf16_t*)(ws + WS_HG_Y)}; GEMM_CALLN(1); }
                GSYNC(); PT_END(5); PT_BEGIN(6);
                { IDS; KParams k = kp_get(); unsigned char* ws = k->ws; float* xctx = (float*)(ws + WS_XCTX); const float* mods = (const float*)(ws + WS_MODS);
                  const float* slat = LPV == 0 ? k->x : k->out; const float* sctx = LPV == 0 ? k->ctx : (const float*)xctx;
                  if (hf == 0)
                      postpre_rows(slat, sctx, k->out, xctx, (const bf16_t*)(ws + WS_HG_Y), mods + (size_t)(2 * LPV) * 9 * 3072, k->norm_post + (2 * LPV) * DM, r0, r1, true,
                                   slat, sctx, mods + (size_t)(2 * LPV) * 9 * 3072, k->norm_pre + (2 * LPV) * DM, (bf16_t*)(ws + WS_HG_H), TH, T, GW, NGW_, lane);
                  else
                      postpre_rows(slat, sctx, k->out, xctx, (const bf16_t*)(ws + WS_HG_Y), mods + (size_t)(2 * LPV) * 9 * 3072, k->norm_post + (2 * LPV) * DM, r0, r1, true,
                                   k->out, xctx, mods + (size_t)(2 * LPV + 1) * 9 * 3072, k->norm_pre + (2 * LPV + 1) * DM, (bf16_t*)(ws + WS_ML_H), 0, T, GW, NGW_, lane); }
                if (hf == 1) { IDS; KParams k = kp_get(); conv_mla_weights(k->mla_w_in, k->mla_w_out, k->mla_w_qb, k->mla_w_kvb, k->ws, LPV, lds, GW, NGW_, wave, lane); }
                GSYNC(); PT_END(6);
}
template <int lp>
__device__ __forceinline__ void mla_layer(LAS unsigned char* lds, unsigned char* lds_raw, cg::grid_group& grid, int& tidv) { PT_BEGIN(7);
                        PT_BEGIN(8);
            { unsigned char* ws = KP(ws);
              pg8::Gemm g{(const bf16_t*)(ws + WS_ML_H), (const bf16_t*)(ws + WS_ML_WIN), T, 2560, DM, DM, DM, 0}; pg8::StaticOrder S; S.init(T, 2560, (int)gridDim.x, opaque_bid());
              pg8::EpiMlaIn E{(bf16_t*)(ws + WS_ML_SMALL), (bf16_t*)(ws + WS_ML_Z)}; GEMM_CALLN(2); }
            GSYNC(); PT_END(8); PT_BEGIN(9);
            { IDS; KParams k = kp_get(); unsigned char* ws = k->ws;
              mla_norm_rows((const bf16_t*)(ws + WS_ML_SMALL), k->mla_qa_norm + LPV * 256, k->mla_kva_norm + LPV * 128, (const float*)(ws + WS_TAB), (bf16_t*)(ws + WS_ML_QN), (bf16_t*)(ws + WS_ML_KC), GW, NGW_, lane); }
            GSYNC(); PT_END(9); PT_BEGIN(10);
            { unsigned char* ws = KP(ws);
              pg8::Gemm g{(const bf16_t*)(ws + WS_ML_QN), (const bf16_t*)(ws + WS_ML_WQ), T, 3072, 256, 256, 256, 0}; pg8::StaticOrder S; S.init(T, 3072, (int)gridDim.x, opaque_bid(), LPV == 1);
              pg8::EpiQ E{(bf16_t*)(ws + WS_ML_QO), (bf16_t*)(ws + WS_ML_QR)}; GEMM_CALLN(3); }
            GSYNC(); PT_END(10); PT_BEGIN(11);
#ifndef NO_ATT
            { unsigned char* ws = KP(ws); bf16_t* QOb = (bf16_t*)(ws + WS_ML_QO); const bf16_t* QRb = (const bf16_t*)(ws + WS_ML_QR); const bf16_t* KCb = (const bf16_t*)(ws + WS_ML_KC);
              for (int u = opaque_bid(); u < (LPV == 1 ? 2048 : 2048 + 128); u += gridDim.x) {
                int b, h, row0, seq, tq0;
                if (u < 2048) { b = u >> 8; h = (u >> 4) & 15; tq0 = (u & 15) * 256; row0 = b * TPB + CTXL + tq0; seq = TPB; }
                else { const int uc = u - 2048; b = uc >> 4; h = uc & 15; row0 = b * TPB; seq = CTXL; tq0 = -1; }
                att::attn_unit(QOb + (size_t)row0 * DI + h * 128, QRb + (size_t)row0 * 1024 + h * 64, KCb + (size_t)b * TPB * 192, QOb + (size_t)row0 * DI + h * 128, seq, (char*)lds_raw, tq0, (const float*)(ws + WS_TAB), (const bf16_t*)(ws + WS_ML_WVB) + (size_t)h * 128 * 128, (const bf16_t*)(ws + WS_ML_Z) + (size_t)row0 * DI + h * 128, tidv);
              } }
#endif
            GSYNC(); PT_END(11); PT_BEGIN(12);
            PT_BEGIN(13);
            { unsigned char* ws = KP(ws);
              pg8::Gemm g{(const bf16_t*)(ws + WS_ML_QO), (const bf16_t*)(ws + WS_ML_WOUT), T, DM, DI, DI, DI, 0}; pg8::StaticOrder S; S.init(T, DM, (int)gridDim.x, opaque_bid(), LPV == 1);
              pg8::EpiF32 E{(bf16_t*)(ws + WS_ML_Y)}; GEMM_CALLN(5); }
            GSYNC(); PT_END(13); PT_BEGIN(14);
            { IDS; KParams k = kp_get(); unsigned char* ws = k->ws; float* xctx = (float*)(ws + WS_XCTX); const float* mods = (const float*)(ws + WS_MODS);
              postpre_rows(k->out, xctx, k->out, xctx, (const bf16_t*)(ws + WS_ML_Y), mods + (size_t)(2 * LPV + 1) * 9 * 3072, k->norm_post + (2 * LPV + 1) * DM, 0, T, LPV == 0,
                           k->out, xctx, mods + (size_t)(2 * LPV + 2) * 9 * 3072, k->norm_pre + (LPV == 0 ? (2 * LPV + 2) * DM : 0), (bf16_t*)(ws + WS_HG_H), 0, LPV == 0 ? TH : 0, GW, NGW_, lane); }
            if (LPV == 0) { { IDS; KParams k = kp_get(); conv_hgrn_weights(k->hg_w_in, k->hg_w_out, k->ws, 1, lds, GW, NGW_, wave, lane); } GSYNC(); } PT_END(14);
}
__global__ void __launch_bounds__(512, 2) mega_fwd(Params p_unused) {
    extern __shared__ __attribute__((aligned(16))) unsigned char lds_raw[];
    LAS unsigned char* lds = (LAS unsigned char*)lds_raw;
    cg::grid_group grid = cg::this_grid();
    int tidv = threadIdx.x;
    { unsigned* bar_ = (unsigned*)(kp_get()->ws) + 1024;
      if (blockIdx.x == 0) for (int i_ = tidv; i_ < XCD_BAR_WORDS; i_ += 512) __hip_atomic_store(bar_ + i_, 0u, __ATOMIC_RELAXED, __HIP_MEMORY_SCOPE_AGENT);
      if (tidv == 0) { volatile LAS unsigned* st_ = (volatile LAS unsigned*)(lds + 147456 - 64); st_[0] = 0u; st_[1] = 0u; } }
    if (PROBE_ID != 0 && blockIdx.x == 0 && tidv == 0) { ((volatile LAS unsigned long long*)(lds + 147456 - 32))[1] = 0ull; }
    PT_BEGIN(15);

    { IDS; KParams k = kp_get(); mods_phase(k->c, k->c_ctx, k->ada_w, k->ada_b, k->ws, lds, tid); }
    __syncthreads();
    { IDS; KParams k = kp_get(); conv_hgrn_weights(k->hg_w_in, k->hg_w_out, k->ws, 0, lds, GW, NGW_, wave, lane); }
    CGSYNC(); PT_END(15);
    { unsigned* bar_ = (unsigned*)(kp_get()->ws) + 1024; const unsigned xcc_ = xb_xcc_id(); if (tidv == 0) (void)xb_add(bar_ + XB_XCNT(xcc_), 1u); }
    { IDS; KParams k = kp_get(); unsigned char* ws = k->ws; pre_rows(k->x, k->ctx, (const float*)(ws + WS_MODS), k->norm_pre, (bf16_t*)(ws + WS_HG_H), 0, TH, GW, NGW_, lane); }
    GSYNC();

    hgrn_pass<0, 0>(lds, lds_raw, grid, tidv); hgrn_pass<0, 1>(lds, lds_raw, grid, tidv);
    mla_layer<0>(lds, lds_raw, grid, tidv);
    hgrn_pass<1, 0>(lds, lds_raw, grid, tidv); hgrn_pass<1, 1>(lds, lds_raw, grid, tidv);
    mla_layer<1>(lds, lds_raw, grid, tidv);
    if (PROBE_ID != 0 && blockIdx.x == 0 && tidv == 0) { const unsigned long long d_ = ((volatile LAS unsigned long long*)(lds + 147456 - 32))[1], t0_ = __builtin_amdgcn_s_memrealtime(); while (__builtin_amdgcn_s_memrealtime() - t0_ < d_) __builtin_amdgcn_s_sleep(8); }
}

extern "C" void kernel_launch(void* const* d_in, const int* in_sizes, int n_in, void* d_out, int out_size, void* d_ws, size_t ws_size, hipStream_t stream) {
    static int grid_blocks = 0;
    if (grid_blocks == 0) {
        if (n_in != 18 || ws_size < 512 * MiB) { fprintf(stderr, "kernel_launch: unexpected n_in %d / ws %zu\n", n_in, ws_size); grid_blocks = -1; return; }
        int dev = 0, cus = 0, per_cu = 0;
        hipGetDevice(&dev);
        hipDeviceGetAttribute(&cus, hipDeviceAttributeMultiprocessorCount, dev);
        if (hipFuncSetAttribute((const void*)mega_fwd, hipFuncAttributeMaxDynamicSharedMemorySize, LDS_BYTES) != hipSuccess) { fprintf(stderr, "kernel_launch: hipFuncSetAttribute failed\n"); grid_blocks = -1; return; }
        if (hipOccupancyMaxActiveBlocksPerMultiprocessor(&per_cu, (const void*)mega_fwd, 512, LDS_BYTES) != hipSuccess || per_cu < 1) { fprintf(stderr, "kernel_launch: occupancy query gave %d\n", per_cu); per_cu = 1; }
        (void)hipGetLastError();
        grid_blocks = cus * per_cu;
    }
    if (grid_blocks < 0) return;
    Params p{};
    p.x = (const float*)d_in[0]; p.c = (const float*)d_in[1]; p.ctx = (const float*)d_in[2]; p.c_ctx = (const float*)d_in[3];
    p.ada_w = (const float*)d_in[4]; p.ada_b = (const float*)d_in[5]; p.norm_pre = (const float*)d_in[6]; p.norm_post = (const float*)d_in[7];
    p.hg_w_in = (const float*)d_in[8]; p.hg_lb = (const float*)d_in[9]; p.hg_o_norm = (const float*)d_in[10]; p.hg_w_out = (const float*)d_in[11];
    p.mla_w_in = (const float*)d_in[12]; p.mla_qa_norm = (const float*)d_in[13]; p.mla_w_qb = (const float*)d_in[14]; p.mla_kva_norm = (const float*)d_in[15];
    p.mla_w_kvb = (const float*)d_in[16]; p.mla_w_out = (const float*)d_in[17];
    p.out = (float*)d_out; p.ws = (unsigned char*)d_ws;
    void* args[] = {&p};
    hipError_t e = hipLaunchCooperativeKernel((const void*)mega_fwd, dim3(grid_blocks), dim3(512), args, LDS_BYTES, stream);
    if (e != hipSuccess) fprintf(stderr, "kernel_launch: cooperative launch failed: %s (grid %d)\n", hipGetErrorString(e), grid_blocks);
}
```
